# Optimizing an MI355X kernel written in HIP

```python
import math
import jax
import jax.numpy as jnp
from jax import lax
import numpy as np

D_MODEL = 1024
BATCH = 1
SEQ = 16384
DEPTH = 1

GRID_W = 64
CTX_LEN = 256
NA_HEADS = 8
NA_DH = 64
NA_W = NA_HEADS * NA_DH
NA_KH = 8
NA_KW = 16
GDN_HEADS = 4
GDN_DK = 128
GDN_DV = 128
GDN_W = GDN_HEADS * GDN_DV
GDN_QKV_W = 2 * GDN_HEADS * GDN_DK + GDN_W
GDN_CHUNK = 64
CONV_K = 5
ROPE_AXIS_DIM = GDN_DK // 2
ROPE_BASE = 10000.0
EPS = 1e-6
MIX_W = NA_W + GDN_W
IN_WIDTHS = (NA_W, NA_W, NA_W, NA_W, GDN_QKV_W, GDN_W, 2 * GDN_HEADS, 2 * GDN_HEADS)
IN_DIM = sum(IN_WIDTHS)
IN_SPLITS = tuple(int(s) for s in np.cumsum(IN_WIDTHS)[:-1])

kernel_name = 'hybrid_natten_gdn_diffusion_block'


def rmsnorm(x, w):
    xf = x.astype(jnp.float32)
    xf = xf * lax.rsqrt(jnp.mean(xf * xf, axis=-1, keepdims=True) + EPS)
    return xf.astype(x.dtype) * w


def l2norm(x):
    xf = x.astype(jnp.float32)
    return xf * lax.rsqrt(jnp.sum(xf * xf, axis=-1, keepdims=True) + EPS)


def rotate_half_axis(x, cos, sin):
    x1, x2 = jnp.split(x, 2, axis=-1)
    c, s = cos[:, None, :], sin[:, None, :]
    return jnp.concatenate([x1 * c - x2 * s, x2 * c + x1 * s], axis=-1)


def axial_rope(x, rope):
    cos_r, sin_r, cos_c, sin_c = rope
    xr, xc = x[..., :ROPE_AXIS_DIM], x[..., ROPE_AXIS_DIM:]
    return jnp.concatenate([rotate_half_axis(xr, cos_r, sin_r),
                            rotate_half_axis(xc, cos_c, sin_c)], axis=-1)


def short_conv(x, w):
    out = lax.conv_general_dilated(
        x, w[:, None, :], window_strides=(1,), padding=[(CONV_K // 2, CONV_K // 2)],
        dimension_numbers=('NWC', 'WIO', 'NWC'), feature_group_count=x.shape[-1])
    return jax.nn.silu(out)


def neighborhood_attention(q, k, v, k_ctx, v_ctx, rpb):
    B, L, H, dh = q.shape
    rows = L // GRID_W
    kh = min(NA_KH, rows)
    scale = dh ** -0.5
    qg = (q * scale).reshape(B, rows, GRID_W, H, dh)
    kg = k.reshape(B, rows, GRID_W, H, dh)
    vg = v.reshape(B, rows, GRID_W, H, dh)
    col = jnp.arange(GRID_W)
    col_start = jnp.clip(col - NA_KW // 2, 0, GRID_W - NA_KW)
    col_idx = col_start[:, None] + jnp.arange(NA_KW)[None, :]
    col_off = col_idx - col[:, None] + NA_KW - 1

    def row_block(r):
        rs = jnp.clip(r - kh // 2, 0, rows - kh)
        k_rows = lax.dynamic_slice_in_dim(kg, rs, kh, axis=1)
        v_rows = lax.dynamic_slice_in_dim(vg, rs, kh, axis=1)
        k_win = k_rows[:, :, col_idx]
        v_win = v_rows[:, :, col_idx]
        q_r = lax.dynamic_index_in_dim(qg, r, axis=1, keepdims=False)
        row_off = rs + jnp.arange(kh) - r + NA_KH - 1
        bias = rpb[:, row_off[:, None, None], col_off[None, :, :]]
        bias = bias.transpose(0, 2, 1, 3).astype(jnp.float32)
        s_loc = jnp.einsum('bchd,bicjhd->bhcij', q_r, k_win).astype(jnp.float32) + bias
        s_ctx = jnp.einsum('bchd,bnhd->bhcn', q_r, k_ctx).astype(jnp.float32)
        s = jnp.concatenate([s_loc.reshape(B, H, GRID_W, kh * NA_KW), s_ctx], axis=-1)
        p = jax.nn.softmax(s, axis=-1).astype(v.dtype)
        p_loc = p[..., :kh * NA_KW].reshape(B, H, GRID_W, kh, NA_KW)
        p_ctx = p[..., kh * NA_KW:]
        return (jnp.einsum('bhcij,bicjhd->bchd', p_loc, v_win)
                + jnp.einsum('bhcn,bnhd->bchd', p_ctx, v_ctx))

    out = lax.map(row_block, jnp.arange(rows))
    return out.transpose(1, 0, 2, 3, 4).reshape(B, L, H * dh)


def context_attention(q, k, v):
    B, Lc, H, dh = q.shape
    s = jnp.einsum('bqhd,bkhd->bhqk', q, k).astype(jnp.float32) * dh ** -0.5
    p = jax.nn.softmax(s, axis=-1).astype(v.dtype)
    return jnp.einsum('bhqk,bkhd->bqhd', p, v).reshape(B, Lc, H * dh)


def gated_delta_chunked(q, k, v, g, beta, state0):
    B, L, H, dk = q.shape
    dv = v.shape[-1]
    n = L // GDN_CHUNK

    def blocks(t):
        return t.reshape(B, n, GDN_CHUNK, H, t.shape[-1]).transpose(1, 0, 3, 2, 4)

    q = blocks(q * dk ** -0.5)
    k = blocks(k)
    v = blocks(v)
    g = g.reshape(B, n, GDN_CHUNK, H).transpose(1, 0, 3, 2)
    beta = beta.reshape(B, n, GDN_CHUNK, H).transpose(1, 0, 3, 2)
    gc = jnp.cumsum(g, axis=-1)
    pos = jnp.arange(GDN_CHUNK)
    incl = pos[:, None] >= pos[None, :]
    decay = jnp.exp(jnp.where(incl, gc[..., :, None] - gc[..., None, :], -jnp.inf))
    kb = k * beta[..., None]
    a = jnp.where(pos[:, None] > pos[None, :],
                  jnp.einsum('nbhid,nbhjd->nbhij', kb, k) * decay, 0.0)
    eye = jnp.eye(GDN_CHUNK, dtype=a.dtype)
    t_inv = lax.linalg.triangular_solve(eye + a, jnp.broadcast_to(eye, a.shape),
                                        left_side=True, lower=True, unit_diagonal=True)
    u = jnp.einsum('nbhij,nbhje->nbhie', t_inv, v * beta[..., None])
    w = jnp.einsum('nbhij,nbhjd->nbhid', t_inv, kb * jnp.exp(gc)[..., None])
    qk = jnp.einsum('nbhid,nbhjd->nbhij', q, k) * decay
    q_dec = q * jnp.exp(gc)[..., None]
    k_dec = k * jnp.exp(gc[..., -1:] - gc)[..., None]
    g_last = jnp.exp(gc[..., -1])

    def step(state, xs):
        u_n, w_n, qk_n, q_n, k_n, gl_n = xs
        v_new = u_n - jnp.einsum('bhcd,bhde->bhce', w_n, state)
        o_n = (jnp.einsum('bhcd,bhde->bhce', q_n, state)
               + jnp.einsum('bhij,bhje->bhie', qk_n, v_new))
        state = state * gl_n[..., None, None] + jnp.einsum('bhcd,bhce->bhde', k_n, v_new)
        return state, o_n

    state, o = lax.scan(step, state0, (u, w, qk, q_dec, k_dec, g_last))
    o = o.transpose(1, 0, 3, 2, 4).reshape(B, L, H, dv)
    return o, state


def gdn_qkv(qkv, conv_w):
    B, L, _ = qkv.shape
    qkv = short_conv(qkv, conv_w).astype(jnp.float32)
    q, k, v = jnp.split(qkv, (GDN_HEADS * GDN_DK, 2 * GDN_HEADS * GDN_DK), axis=-1)
    q = l2norm(q.reshape(B, L, GDN_HEADS, GDN_DK))
    k = l2norm(k.reshape(B, L, GDN_HEADS, GDN_DK))
    v = v.reshape(B, L, GDN_HEADS, GDN_DV)
    return q, k, v


def gdn_gates(b, a, A_log, dt_bias):
    B, L, _ = b.shape
    b = b.reshape(B, L, 2, GDN_HEADS).astype(jnp.float32)
    a = a.reshape(B, L, 2, GDN_HEADS).astype(jnp.float32)
    beta = jax.nn.sigmoid(b)
    g = -jnp.exp(A_log.astype(jnp.float32)) * jax.nn.softplus(a + dt_bias.astype(jnp.float32))
    return beta, g


def bidirectional_gdn(q, k, v, g, beta, qc, kc, vc, gc, betac):
    B = q.shape[0]
    zero = jnp.zeros((B, GDN_HEADS, GDN_DK, GDN_DV), jnp.float32)
    flip = lambda t: jnp.flip(t, axis=1)
    oc_f, s_f = gated_delta_chunked(qc, kc, vc, gc[:, :, 0], betac[:, :, 0], zero)
    oc_b, s_b = gated_delta_chunked(flip(qc), flip(kc), flip(vc),
                                    flip(gc[:, :, 1]), flip(betac[:, :, 1]), zero)
    o_f, _ = gated_delta_chunked(q, k, v, g[:, :, 0], beta[:, :, 0], s_f)
    o_b, _ = gated_delta_chunked(flip(q), flip(k), flip(v),
                                 flip(g[:, :, 1]), flip(beta[:, :, 1]), s_b)
    return o_f + flip(o_b), oc_f + flip(oc_b)


def hybrid_layer(x, xc, c, c_ctx, w_ada, b_ada, g_pre, g_post, w_in, conv_w, rpb,
                 A_log, dt_bias, gdn_norm_w, w_out, rope, update_ctx):
    B, L, _ = x.shape
    Lc = xc.shape[1]
    shift, scale, gate = jnp.split(jax.nn.silu(c) @ w_ada + b_ada, 3, axis=-1)
    shift_c, scale_c, gate_c = jnp.split(jax.nn.silu(c_ctx) @ w_ada + b_ada, 3, axis=-1)
    h = rmsnorm(x, g_pre) * (1.0 + scale[:, None]) + shift[:, None]
    hc = rmsnorm(xc, g_pre) * (1.0 + scale_c) + shift_c
    na_q, na_k, na_v, na_z, g_qkv, g_z, g_b, g_a = jnp.split(h @ w_in, IN_SPLITS, axis=-1)
    na_qc, na_kc, na_vc, na_zc, g_qkvc, g_zc, g_bc, g_ac = jnp.split(hc @ w_in, IN_SPLITS, axis=-1)
    heads = lambda t: t.reshape(t.shape[0], t.shape[1], NA_HEADS, NA_DH)

    o_na = neighborhood_attention(heads(na_q), heads(na_k), heads(na_v),
                                  heads(na_kc), heads(na_vc), rpb)

    q, k, v = gdn_qkv(g_qkv, conv_w)
    q, k = axial_rope(q, rope), axial_rope(k, rope)
    qc, kc, vc = gdn_qkv(g_qkvc, conv_w)
    beta, g = gdn_gates(g_b, g_a, A_log, dt_bias)
    betac, gc = gdn_gates(g_bc, g_ac, A_log, dt_bias)
    o_g, o_gc = bidirectional_gdn(q, k, v, g, beta, qc, kc, vc, gc, betac)
    o_g = rmsnorm(o_g, gdn_norm_w).reshape(B, L, GDN_W).astype(x.dtype)

    y = jnp.concatenate([o_na * jax.nn.silu(na_z), o_g * jax.nn.silu(g_z)], axis=-1) @ w_out
    x = x + gate[:, None] * rmsnorm(y, g_post)

    if update_ctx:
        o_nac = context_attention(heads(na_qc), heads(na_kc), heads(na_vc))
        o_gc = rmsnorm(o_gc, gdn_norm_w).reshape(B, Lc, GDN_W).astype(xc.dtype)
        yc = jnp.concatenate([o_nac * jax.nn.silu(na_zc), o_gc * jax.nn.silu(g_zc)], axis=-1) @ w_out
        xc = xc + gate_c * rmsnorm(yc, g_post)
    return x, xc


def setup_inputs(seed: int = 0) -> dict:
    key = jax.random.key(seed)
    ks = jax.random.split(key, 16)
    f32 = jnp.float32
    nrm = lambda kk, shape, s: jax.random.normal(kk, shape, f32) * s
    x = nrm(ks[0], (BATCH, SEQ, D_MODEL), 1.0)
    c = nrm(ks[1], (BATCH, D_MODEL), 1.0)
    ctx = nrm(ks[2], (BATCH, CTX_LEN, D_MODEL), 1.0)
    c_ctx = nrm(ks[3], (D_MODEL,), 1.0)
    w_ada = nrm(ks[4], (DEPTH, D_MODEL, 3 * D_MODEL), 0.5 * D_MODEL ** -0.5)
    b_ada = nrm(ks[5], (DEPTH, 3 * D_MODEL), 0.01)
    g_pre = 1.0 + nrm(ks[6], (DEPTH, D_MODEL), 0.02)
    g_post = 1.0 + nrm(ks[7], (DEPTH, D_MODEL), 0.02)
    w_in = nrm(ks[8], (DEPTH, D_MODEL, IN_DIM), D_MODEL ** -0.5)
    conv_w = nrm(ks[9], (DEPTH, CONV_K, GDN_QKV_W), CONV_K ** -0.5)
    rpb = nrm(ks[10], (DEPTH, NA_HEADS, 2 * NA_KH - 1, 2 * NA_KW - 1), 0.1)
    A_log = jnp.log(jax.random.uniform(ks[11], (DEPTH, 2, GDN_HEADS), f32, 1.0, 16.0))
    dt = jnp.exp(jax.random.uniform(ks[12], (DEPTH, 2, GDN_HEADS), f32,
                                    math.log(1e-3), math.log(1e-1)))
    dt_bias = dt + jnp.log(-jnp.expm1(-dt))
    gdn_norm_w = 1.0 + nrm(ks[13], (DEPTH, GDN_DV), 0.02)
    w_out = nrm(ks[14], (DEPTH, MIX_W, D_MODEL), MIX_W ** -0.5)
    return {'x': x, 'c': c, 'ctx': ctx, 'c_ctx': c_ctx, 'w_ada': w_ada, 'b_ada': b_ada,
            'g_pre': g_pre, 'g_post': g_post, 'w_in': w_in, 'conv_w': conv_w, 'rpb': rpb,
            'A_log': A_log, 'dt_bias': dt_bias, 'gdn_norm_w': gdn_norm_w, 'w_out': w_out}


def reference(x, c, ctx, c_ctx, w_ada, b_ada, g_pre, g_post, w_in, conv_w, rpb,
              A_log, dt_bias, gdn_norm_w, w_out):
    L = x.shape[1]
    t = jnp.arange(L)
    row = (t // GRID_W).astype(jnp.float32)
    col = (t % GRID_W).astype(jnp.float32)
    inv_freq = ROPE_BASE ** (-jnp.arange(0, ROPE_AXIS_DIM, 2, dtype=jnp.float32) / ROPE_AXIS_DIM)
    ang_r = row[:, None] * inv_freq[None, :]
    ang_c = col[:, None] * inv_freq[None, :]
    rope = (jnp.cos(ang_r), jnp.sin(ang_r), jnp.cos(ang_c), jnp.sin(ang_c))
    xc = ctx
    for layer in range(DEPTH):
        x, xc = hybrid_layer(x, xc, c, c_ctx, w_ada[layer], b_ada[layer], g_pre[layer],
                             g_post[layer], w_in[layer], conv_w[layer], rpb[layer],
                             A_log[layer], dt_bias[layer], gdn_norm_w[layer], w_out[layer],
                             rope, update_ctx=(layer < DEPTH - 1))
    return x
```

```cpp
#include <hip/hip_runtime.h>
#include <hip/hip_fp16.h>
#include <hip/hip_cooperative_groups.h>
#include <cstdio>
namespace cg = cooperative_groups;

#ifndef MK_MULTI
#define MK_MULTI 0
#endif

constexpr int L = 16384, CTX = 256, LT = L + CTX, D = 1024, IN_DIM = 4112;
constexpr int GW = 64;
constexpr float EPS = 1e-6f;

struct Params {
  const float *x, *c, *ctx, *c_ctx, *w_ada, *b_ada, *g_pre, *g_post, *w_in, *conv_w, *rpb, *A_log, *dt_bias,
      *gdn_norm_w, *w_out;
  float* out;
  float* mod;
  __half* H;
  __half* NAP;
  __half* GQ;
  __half* GZ;
  float* GBA;
  __half* QKV;
  float* BETA;
  float* GG;
  __half* OF;
  __half* OB;
  __half* MIX;
  float* Y;
};

__device__ inline float wsum(float v) {
#pragma unroll
  for (int o = 32; o > 0; o >>= 1) v += __shfl_xor(v, o, 64);
  return v;
}
__device__ inline float wmax(float v) {
#pragma unroll
  for (int o = 32; o > 0; o >>= 1) v = fmaxf(v, __shfl_xor(v, o, 64));
  return v;
}
__device__ inline float siluf(float x) { return x / (1.f + __expf(-x)); }

__device__ void phaseA(const Params& p, float* smem) {
  int tid = threadIdx.x, lane = tid & 63, w = tid >> 6;
  for (int item = blockIdx.x; item < 48; item += gridDim.x) {
    int j = item * 64 + lane;
    float a0 = 0.f, a1 = 0.f;
    int k0 = w * 256;
#pragma unroll 8
    for (int k = k0; k < k0 + 256; ++k) {
      float wv = p.w_ada[(size_t)k * 3072 + j];
      a0 += siluf(p.c[k]) * wv;
      a1 += siluf(p.c_ctx[k]) * wv;
    }
    __syncthreads();
    smem[(w * 2 + 0) * 64 + lane] = a0;
    smem[(w * 2 + 1) * 64 + lane] = a1;
    __syncthreads();
    if (w < 2) {
      float s = smem[(0 * 2 + w) * 64 + lane] + smem[(1 * 2 + w) * 64 + lane] + smem[(2 * 2 + w) * 64 + lane] +
                smem[(3 * 2 + w) * 64 + lane];
      p.mod[w * 3072 + j] = s + p.b_ada[j];
    }
  }
}

__device__ void phaseB(const Params& p) {
  int lane = threadIdx.x & 63;
  int gw = blockIdx.x * 4 + (threadIdx.x >> 6);
  int nw = gridDim.x * 4;
  for (int r = gw; r < LT; r += nw) {
    const float* src = (r < L) ? p.x + (size_t)r * D : p.ctx + (size_t)(r - L) * D;
    const float* md = p.mod + ((r < L) ? 0 : 3072);
    float4 v[4];
    float ss = 0.f;
#pragma unroll
    for (int i = 0; i < 4; ++i) {
      v[i] = *(const float4*)(src + i * 256 + lane * 4);
      ss += v[i].x * v[i].x + v[i].y * v[i].y + v[i].z * v[i].z + v[i].w * v[i].w;
    }
    ss = wsum(ss);
    float inv = rsqrtf(ss * (1.f / D) + EPS);
#pragma unroll
    for (int i = 0; i < 4; ++i) {
      int j = i * 256 + lane * 4;
      float4 g = *(const float4*)(p.g_pre + j);
      float4 sh = *(const float4*)(md + j);
      float4 sc = *(const float4*)(md + 1024 + j);
      float o0 = v[i].x * inv * g.x * (1.f + sc.x) + sh.x;
      float o1 = v[i].y * inv * g.y * (1.f + sc.y) + sh.y;
      float o2 = v[i].z * inv * g.z * (1.f + sc.z) + sh.z;
      float o3 = v[i].w * inv * g.w * (1.f + sc.w) + sh.w;
      __half2 h0 = __floats2half2_rn(o0, o1), h1 = __floats2half2_rn(o2, o3);
      __half2* dst = (__half2*)(p.H + (size_t)r * D + j);
      dst[0] = h0;
      dst[1] = h1;
    }
  }
}

template <class Epi>
__device__ void gemm_naive(const __half* A, int lda, const float* W, int ldw, int M, int N, int K, float* smem,
                           Epi epi) {
  float(*As)[68] = (float(*)[68])smem;
  float(*Bs)[68] = (float(*)[68])(smem + 16 * 68);
  int tid = threadIdx.x;
  int tx = tid & 15, ty = tid >> 4;
  int mt = M / 64, nt = (N + 63) / 64;
  for (int tile = blockIdx.x; tile < mt * nt; tile += gridDim.x) {
    int tm = tile / nt, tn = tile % nt;
    float acc[4][4];
#pragma unroll
    for (int i = 0; i < 4; ++i)
#pragma unroll
      for (int j = 0; j < 4; ++j) acc[i][j] = 0.f;
    for (int k0 = 0; k0 < K; k0 += 16) {
      {
        int r = tid >> 2, kk = (tid & 3) * 4;
        const __half2* ap = (const __half2*)(A + (size_t)(tm * 64 + r) * lda + k0 + kk);
        float2 f0 = __half22float2(ap[0]), f1 = __half22float2(ap[1]);
        As[kk + 0][r] = f0.x;
        As[kk + 1][r] = f0.y;
        As[kk + 2][r] = f1.x;
        As[kk + 3][r] = f1.y;
      }
      {
        int kk = tid >> 4, n = (tid & 15) * 4;
#pragma unroll
        for (int i = 0; i < 4; ++i) {
          int col = tn * 64 + n + i;
          Bs[kk][n + i] = (col < N) ? W[(size_t)(k0 + kk) * ldw + col] : 0.f;
        }
      }
      __syncthreads();
#pragma unroll
      for (int kk = 0; kk < 16; ++kk) {
        float a[4], b[4];
#pragma unroll
        for (int i = 0; i < 4; ++i) a[i] = As[kk][ty * 4 + i];
#pragma unroll
        for (int j = 0; j < 4; ++j) b[j] = Bs[kk][tx * 4 + j];
#pragma unroll
        for (int i = 0; i < 4; ++i)
#pragma unroll
          for (int j = 0; j < 4; ++j) acc[i][j] += a[i] * b[j];
      }
      __syncthreads();
    }
#pragma unroll
    for (int i = 0; i < 4; ++i)
#pragma unroll
      for (int j = 0; j < 4; ++j) {
        int col = tn * 64 + tx * 4 + j;
        if (col < N) epi(tm * 64 + ty * 4 + i, col, acc[i][j]);
      }
  }
}

__device__ void phaseC(const Params& p, float* smem) {
  auto epi = [&](int m, int n, float v) {
    if (n < 2048)
      p.NAP[(size_t)m * 2048 + n] = __float2half(v);
    else if (n < 3584)
      p.GQ[(size_t)m * 1536 + (n - 2048)] = __float2half(v);
    else if (n < 4096)
      p.GZ[(size_t)m * 512 + (n - 3584)] = __float2half(v);
    else
      p.GBA[(size_t)m * 16 + (n - 4096)] = v;
  };
  gemm_naive(p.H, D, p.w_in, IN_DIM, LT, IN_DIM, D, smem, epi);
}

__device__ void phaseD_gdnpre(const Params& p) {
  int lane = threadIdx.x & 63;
  int gw = blockIdx.x * 4 + (threadIdx.x >> 6);
  int nw = gridDim.x * 4;
  int axis = lane >> 5, fi = lane & 31;
  int d1 = axis * 64 + fi, d2 = d1 + 32;
  float inv_freq = powf(10000.f, -(float)(2 * fi) / 64.f);
  for (int item = gw; item < LT * 12; item += nw) {
    int r = item / 12, grp = item % 12;
    int pos, len, base;
    if (r < L) {
      pos = r; len = L; base = 0;
    } else {
      pos = r - L; len = CTX; base = L;
    }
    int ch1 = grp * 128 + d1, ch2 = grp * 128 + d2;
    float a1 = 0.f, a2 = 0.f;
#pragma unroll
    for (int j = 0; j < 5; ++j) {
      int pp = pos + j - 2;
      if (pp >= 0 && pp < len) {
        const __half* row = p.GQ + (size_t)(base + pp) * 1536;
        a1 += p.conv_w[j * 1536 + ch1] * __half2float(row[ch1]);
        a2 += p.conv_w[j * 1536 + ch2] * __half2float(row[ch2]);
      }
    }
    a1 = siluf(a1);
    a2 = siluf(a2);
    if (grp < 8) {
      float ss = wsum(a1 * a1 + a2 * a2);
      float inv = rsqrtf(ss + EPS);
      a1 *= inv;
      a2 *= inv;
      if (r < L) {
        float posv = (axis == 0) ? (float)(pos / GW) : (float)(pos % GW);
        float ang = posv * inv_freq;
        float cs = cosf(ang), sn = sinf(ang);
        float n1 = a1 * cs - a2 * sn;
        float n2 = a2 * cs + a1 * sn;
        a1 = n1;
        a2 = n2;
      }
    }
    p.QKV[(size_t)r * 1536 + ch1] = __float2half(a1);
    p.QKV[(size_t)r * 1536 + ch2] = __float2half(a2);
    if (grp == 0 && lane < 8) {
      float b = p.GBA[(size_t)r * 16 + lane];
      float a = p.GBA[(size_t)r * 16 + 8 + lane];
      float beta = 1.f / (1.f + __expf(-b));
      float xx = a + p.dt_bias[lane];
      float sp = (xx > 20.f) ? xx : log1pf(expf(xx));
      float g = -expf(p.A_log[lane]) * sp;
      p.BETA[(size_t)r * 8 + lane] = beta;
      p.GG[(size_t)r * 8 + lane] = g;
    }
  }
}

__device__ void phaseD_na(const Params& p, float* smem) {
  int lane = threadIdx.x & 63, w = threadIdx.x >> 6;
  int gw = blockIdx.x * 4 + w;
  int nw = gridDim.x * 4;
  float* qs = smem + w * 512;
  float* ps = smem + w * 512 + 64;
  for (int item = gw; item < L * 8; item += nw) {
    int t = item >> 3, h = item & 7;
    int r = t / GW, c = t % GW;
    int rs = min(max(r - 4, 0), 256 - 8);
    int cs = min(max(c - 8, 0), GW - 16);
    qs[lane] = __half2float(p.NAP[(size_t)t * 2048 + h * 64 + lane]) * 0.125f;
    __builtin_amdgcn_wave_barrier();
    __builtin_amdgcn_s_waitcnt(0xc07f);
    float s[6];
#pragma unroll
    for (int kk = 0; kk < 6; ++kk) {
      int kidx = lane + 64 * kk;
      int tok;
      float bias = 0.f;
      if (kk < 2) {
        int i = kidx >> 4, j = kidx & 15;
        tok = (rs + i) * GW + cs + j;
        bias = p.rpb[h * (15 * 31) + (rs + i - r + 7) * 31 + (cs + j - c + 15)];
      } else {
        tok = L + (kidx - 128);
      }
      const uint4* kp = (const uint4*)(p.NAP + (size_t)tok * 2048 + 512 + h * 64);
      float dot = 0.f;
#pragma unroll
      for (int u = 0; u < 8; ++u) {
        uint4 kv = kp[u];
        const __half2* h2 = (const __half2*)&kv;
#pragma unroll
        for (int e = 0; e < 4; ++e) {
          float2 f = __half22float2(h2[e]);
          dot += f.x * qs[u * 8 + e * 2] + f.y * qs[u * 8 + e * 2 + 1];
        }
      }
      s[kk] = dot + bias;
    }
    float m = s[0];
#pragma unroll
    for (int kk = 1; kk < 6; ++kk) m = fmaxf(m, s[kk]);
    m = wmax(m);
    float sum = 0.f;
#pragma unroll
    for (int kk = 0; kk < 6; ++kk) {
      s[kk] = __expf(s[kk] - m);
      sum += s[kk];
    }
    sum = wsum(sum);
    float rinv = 1.f / sum;
#pragma unroll
    for (int kk = 0; kk < 6; ++kk) ps[lane + 64 * kk] = s[kk] * rinv;
    __builtin_amdgcn_wave_barrier();
    __builtin_amdgcn_s_waitcnt(0xc07f);
    float o = 0.f;
    for (int key = 0; key < 128; ++key) {
      int i = key >> 4, j = key & 15;
      int tok = (rs + i) * GW + cs + j;
      o += ps[key] * __half2float(p.NAP[(size_t)tok * 2048 + 1024 + h * 64 + lane]);
    }
    for (int key = 0; key < 256; ++key) {
      o += ps[128 + key] * __half2float(p.NAP[(size_t)(L + key) * 2048 + 1024 + h * 64 + lane]);
    }
    float z = __half2float(p.NAP[(size_t)t * 2048 + 1536 + h * 64 + lane]);
    p.MIX[(size_t)t * 1024 + h * 64 + lane] = __float2half(o * siluf(z));
    __builtin_amdgcn_wave_barrier();
  }
}

__device__ inline int seqrow(int dir, int n) {
  if (dir == 0) return (n < CTX) ? (L + n) : (n - CTX);
  return (n < CTX) ? (L + CTX - 1 - n) : (L - 1 - (n - CTX));
}

__device__ void phaseE(const Params& p, float* smem) {
  if (blockIdx.x >= 8) return;
  constexpr int TB = 8;
  int chain = blockIdx.x, dir = chain >> 2, hd = chain & 3;
  int tid = threadIdx.x;
  float* ks = smem;
  float* qs = smem + TB * 128;
  float* vs = smem + 2 * TB * 128;
  float* al = smem + 3 * TB * 128;
  float* be = al + TB;
  __half* Od = dir ? p.OB : p.OF;
  float S[128];
#pragma unroll
  for (int d = 0; d < 128; ++d) S[d] = 0.f;
  __half st[12];
  float sg = 0.f;
  const int nb = LT / TB;
  auto prefetch = [&](int b) {
#pragma unroll
    for (int i = 0; i < 12; ++i) {
      int e = tid + 256 * i;
      int arr = e / (TB * 128), tok = (e >> 7) & (TB - 1), d = e & 127;
      int row = seqrow(dir, b * TB + tok);
      int col = ((arr == 0) ? 512 : (arr == 1) ? 0 : 1024) + hd * 128 + d;
      st[i] = p.QKV[(size_t)row * 1536 + col];
    }
    if (tid < TB) {
      int row = seqrow(dir, b * TB + tid);
      sg = __expf(p.GG[(size_t)row * 8 + dir * 4 + hd]);
    } else if (tid < 2 * TB) {
      int row = seqrow(dir, b * TB + tid - TB);
      sg = p.BETA[(size_t)row * 8 + dir * 4 + hd];
    }
  };
  prefetch(0);
  const float scale = 0.08838834764831845f;
  for (int b = 0; b < nb; ++b) {
    __syncthreads();
#pragma unroll
    for (int i = 0; i < 12; ++i) smem[tid + 256 * i] = __half2float(st[i]);
    if (tid < 2 * TB) al[tid] = sg;
    __syncthreads();
    if (b + 1 < nb) prefetch(b + 1);
    if (tid < 128) {
      for (int tok = 0; tok < TB; ++tok) {
        const float4* k4 = (const float4*)(ks + tok * 128);
        const float4* q4 = (const float4*)(qs + tok * 128);
        float alpha = al[tok], beta = be[tok];
        float pk = 0.f;
#pragma unroll
        for (int d4 = 0; d4 < 32; ++d4) {
          float4 kv = k4[d4];
          pk += S[4 * d4] * kv.x + S[4 * d4 + 1] * kv.y + S[4 * d4 + 2] * kv.z + S[4 * d4 + 3] * kv.w;
        }
        float vn = beta * (vs[tok * 128 + tid] - alpha * pk);
        float oq = 0.f;
#pragma unroll
        for (int d4 = 0; d4 < 32; ++d4) {
          float4 kv = k4[d4];
          float4 qv = q4[d4];
          S[4 * d4] = alpha * S[4 * d4] + kv.x * vn;
          S[4 * d4 + 1] = alpha * S[4 * d4 + 1] + kv.y * vn;
          S[4 * d4 + 2] = alpha * S[4 * d4 + 2] + kv.z * vn;
          S[4 * d4 + 3] = alpha * S[4 * d4 + 3] + kv.w * vn;
          oq += S[4 * d4] * qv.x + S[4 * d4 + 1] * qv.y + S[4 * d4 + 2] * qv.z + S[4 * d4 + 3] * qv.w;
        }
        int n = b * TB + tok;
        if (n >= CTX) {
          int row = seqrow(dir, n);
          Od[(size_t)row * 512 + hd * 128 + tid] = __float2half(oq * scale);
        }
      }
    }
  }
}

__device__ void phaseF(const Params& p) {
  int lane = threadIdx.x & 63;
  int gw = blockIdx.x * 4 + (threadIdx.x >> 6);
  int nw = gridDim.x * 4;
  for (int item = gw; item < L * 4; item += nw) {
    int t = item >> 2, h = item & 3;
    size_t o = (size_t)t * 512 + h * 128;
    float v1 = __half2float(p.OF[o + lane]) + __half2float(p.OB[o + lane]);
    float v2 = __half2float(p.OF[o + lane + 64]) + __half2float(p.OB[o + lane + 64]);
    float ss = wsum(v1 * v1 + v2 * v2);
    float inv = rsqrtf(ss * (1.f / 128.f) + EPS);
    float z1 = __half2float(p.GZ[o + lane]), z2 = __half2float(p.GZ[o + lane + 64]);
    p.MIX[(size_t)t * 1024 + 512 + h * 128 + lane] = __float2half(v1 * inv * p.gdn_norm_w[lane] * siluf(z1));
    p.MIX[(size_t)t * 1024 + 512 + h * 128 + lane + 64] =
        __float2half(v2 * inv * p.gdn_norm_w[lane + 64] * siluf(z2));
  }
}

__device__ void phaseG(const Params& p, float* smem) {
  auto epi = [&](int m, int n, float v) { p.Y[(size_t)m * 1024 + n] = v; };
  gemm_naive(p.MIX, 1024, p.w_out, 1024, L, 1024, 1024, smem, epi);
}

__device__ void phaseH(const Params& p) {
  int lane = threadIdx.x & 63;
  int gw = blockIdx.x * 4 + (threadIdx.x >> 6);
  int nw = gridDim.x * 4;
  for (int r = gw; r < L; r += nw) {
    const float* src = p.Y + (size_t)r * D;
    float4 v[4];
    float ss = 0.f;
#pragma unroll
    for (int i = 0; i < 4; ++i) {
      v[i] = *(const float4*)(src + i * 256 + lane * 4);
      ss += v[i].x * v[i].x + v[i].y * v[i].y + v[i].z * v[i].z + v[i].w * v[i].w;
    }
    ss = wsum(ss);
    float inv = rsqrtf(ss * (1.f / D) + EPS);
#pragma unroll
    for (int i = 0; i < 4; ++i) {
      int j = i * 256 + lane * 4;
      float4 g = *(const float4*)(p.g_post + j);
      float4 gt = *(const float4*)(p.mod + 2048 + j);
      float4 xv = *(const float4*)(p.x + (size_t)r * D + j);
      float4 o;
      o.x = xv.x + gt.x * (v[i].x * inv * g.x);
      o.y = xv.y + gt.y * (v[i].y * inv * g.y);
      o.z = xv.z + gt.z * (v[i].z * inv * g.z);
      o.w = xv.w + gt.w * (v[i].w * inv * g.w);
      *(float4*)(p.out + (size_t)r * D + j) = o;
    }
  }
}

constexpr int SMEM_FLOATS = 4096;

template <int PH>
__device__ void run_phase(const Params& p, float* smem) {
  if constexpr (PH == 0) phaseA(p, smem);
  if constexpr (PH == 1) phaseB(p);
  if constexpr (PH == 2) phaseC(p, smem);
  if constexpr (PH == 3) {
    phaseD_gdnpre(p);
    phaseD_na(p, smem);
  }
  if constexpr (PH == 4) phaseE(p, smem);
  if constexpr (PH == 5) phaseF(p);
  if constexpr (PH == 6) phaseG(p, smem);
  if constexpr (PH == 7) phaseH(p);
}

__global__ void __launch_bounds__(256) mega(Params p) {
  __shared__ float smem[SMEM_FLOATS];
  cg::grid_group grid = cg::this_grid();
  run_phase<0>(p, smem); grid.sync();
  run_phase<1>(p, smem); grid.sync();
  run_phase<2>(p, smem); grid.sync();
  run_phase<3>(p, smem); grid.sync();
  run_phase<4>(p, smem); grid.sync();
  run_phase<5>(p, smem); grid.sync();
  run_phase<6>(p, smem); grid.sync();
  run_phase<7>(p, smem);
}

template <int PH>
__global__ void __launch_bounds__(256) phase_k(Params p) {
  __shared__ float smem[SMEM_FLOATS];
  run_phase<PH>(p, smem);
}

extern "C" void kernel_launch(void* const* d_in, const int* in_sizes, int n_in, void* d_out, int out_size, void* d_ws,
                              size_t ws_size, hipStream_t stream) {
  Params p{};
  p.x = (const float*)d_in[0];
  p.c = (const float*)d_in[1];
  p.ctx = (const float*)d_in[2];
  p.c_ctx = (const float*)d_in[3];
  p.w_ada = (const float*)d_in[4];
  p.b_ada = (const float*)d_in[5];
  p.g_pre = (const float*)d_in[6];
  p.g_post = (const float*)d_in[7];
  p.w_in = (const float*)d_in[8];
  p.conv_w = (const float*)d_in[9];
  p.rpb = (const float*)d_in[10];
  p.A_log = (const float*)d_in[11];
  p.dt_bias = (const float*)d_in[12];
  p.gdn_norm_w = (const float*)d_in[13];
  p.w_out = (const float*)d_in[14];
  p.out = (float*)d_out;
  char* ws = (char*)d_ws;
  size_t off = 0;
  auto take = [&](size_t bytes) {
    char* q = ws + off;
    off += (bytes + 255) & ~(size_t)255;
    return q;
  };
  p.mod = (float*)take(2 * 3072 * 4);
  p.H = (__half*)take((size_t)LT * 1024 * 2);
  p.MIX = p.H;
  p.NAP = (__half*)take((size_t)LT * 2048 * 2);
  p.Y = (float*)p.NAP;
  p.GQ = (__half*)take((size_t)LT * 1536 * 2);
  p.OF = p.GQ;
  p.OB = p.GQ + (size_t)L * 512;
  p.GZ = (__half*)take((size_t)LT * 512 * 2);
  p.GBA = (float*)take((size_t)LT * 16 * 4);
  p.QKV = (__half*)take((size_t)LT * 1536 * 2);
  p.BETA = (float*)take((size_t)LT * 8 * 4);
  p.GG = (float*)take((size_t)LT * 8 * 4);

#if MK_MULTI
  int g = 1024;
  phase_k<0><<<g, 256, 0, stream>>>(p);
  phase_k<1><<<g, 256, 0, stream>>>(p);
  phase_k<2><<<g, 256, 0, stream>>>(p);
  phase_k<3><<<g, 256, 0, stream>>>(p);
  phase_k<4><<<g, 256, 0, stream>>>(p);
  phase_k<5><<<g, 256, 0, stream>>>(p);
  phase_k<6><<<g, 256, 0, stream>>>(p);
  phase_k<7><<<g, 256, 0, stream>>>(p);
#else
  static int grid_blocks = 0;
  if (!grid_blocks) {
    int dev = 0, cus = 0, per_cu = 0;
    hipGetDevice(&dev);
    hipDeviceGetAttribute(&cus, hipDeviceAttributeMultiprocessorCount, dev);
    hipOccupancyMaxActiveBlocksPerMultiprocessor(&per_cu, mega, 256, 0);
    if (per_cu < 1) per_cu = 1;
    grid_blocks = cus * per_cu;
  }
  void* args[] = {&p};
  hipError_t e = hipLaunchCooperativeKernel((void*)mega, dim3(grid_blocks), dim3(256), args, 0, stream);
  if (e != hipSuccess) fprintf(stderr, "cooperative launch failed: %s (grid %d)\n", hipGetErrorString(e), grid_blocks);
#endif
}
```

```cpp
#include <hip/hip_runtime.h>
#include <hip/hip_fp16.h>
#include <hip/hip_cooperative_groups.h>
#include <cstdio>
namespace cg = cooperative_groups;

#ifndef MK_MULTI
#define MK_MULTI 0
#endif

constexpr int L = 16384, CTX = 256, LT = L + CTX, D = 1024, IN_DIM = 4112;
constexpr int NT = 512, NWV = NT / 64;
constexpr int NPAD = 4352;
constexpr int LDS_BYTES = 139264;
typedef _Float16 f16x8 __attribute__((ext_vector_type(8)));
typedef _Float16 f16x4 __attribute__((ext_vector_type(4)));
typedef float f32x4 __attribute__((ext_vector_type(4)));
constexpr int GW = 64;
constexpr float EPS = 1e-6f;

struct Params {
  const float *x, *c, *ctx, *c_ctx, *w_ada, *b_ada, *g_pre, *g_post, *w_in, *conv_w, *rpb, *A_log, *dt_bias,
      *gdn_norm_w, *w_out;
  float* out;
  float* mod;
  __half* WtI;
  __half* WtO;
  __half* H;
  __half* NAP;
  __half* GQ;
  __half* GZ;
  float* GBA;
  __half* QKV;
  float* BETA;
  float* GG;
  __half* TB;
  __half* QKM;
  float* SC;
  __half* OF;
  __half* OB;
  __half* MIX;
  float* Y;
};

__device__ inline float wsum(float v) {
#pragma unroll
  for (int o = 32; o > 0; o >>= 1) v += __shfl_xor(v, o, 64);
  return v;
}
__device__ inline float wmax(float v) {
#pragma unroll
  for (int o = 32; o > 0; o >>= 1) v = fmaxf(v, __shfl_xor(v, o, 64));
  return v;
}
__device__ inline float siluf(float x) { return x / (1.f + __expf(-x)); }

__device__ void transpose_tiles(const float* W, int ld, int Nvalid, int Npad, __half* Wt, float* smem, int tid) {
  int tn = Npad / 64;
  for (int tile = blockIdx.x; tile < 16 * tn; tile += gridDim.x) {
    int tk = tile / tn, tc = tile % tn;
    __syncthreads();
#pragma unroll
    for (int i = 0; i < 8; ++i) {
      int e = tid + NT * i;
      int kk = e >> 6, nn = e & 63;
      int col = tc * 64 + nn;
      smem[kk * 65 + nn] = (col < Nvalid) ? W[(size_t)(tk * 64 + kk) * ld + col] : 0.f;
    }
    __syncthreads();
    {
      int nn = tid >> 3, k8 = (tid & 7) * 8;
      __half2 h[4];
#pragma unroll
      for (int i = 0; i < 4; ++i)
        h[i] = __floats2half2_rn(smem[(k8 + 2 * i) * 65 + nn], smem[(k8 + 2 * i + 1) * 65 + nn]);
      *(uint4*)(Wt + (size_t)(tc * 64 + nn) * 1024 + tk * 64 + k8) = *(uint4*)h;
    }
  }
}

__device__ void phaseA(const Params& p, float* smem, int tid) {
  int lane = tid & 63, w = tid >> 6;
  for (int item = blockIdx.x; item < 48; item += gridDim.x) {
    int j = item * 64 + lane;
    float a0 = 0.f, a1 = 0.f;
    int k0 = w * 128;
#pragma unroll 8
    for (int k = k0; k < k0 + 128; ++k) {
      float wv = p.w_ada[(size_t)k * 3072 + j];
      a0 += siluf(p.c[k]) * wv;
      a1 += siluf(p.c_ctx[k]) * wv;
    }
    __syncthreads();
    smem[(w * 2 + 0) * 64 + lane] = a0;
    smem[(w * 2 + 1) * 64 + lane] = a1;
    __syncthreads();
    if (w < 2) {
      float s = 0.f;
#pragma unroll
      for (int ww = 0; ww < NWV; ++ww) s += smem[(ww * 2 + w) * 64 + lane];
      p.mod[w * 3072 + j] = s + p.b_ada[j];
    }
  }
  transpose_tiles(p.w_in, IN_DIM, IN_DIM, NPAD, p.WtI, smem, tid);
  transpose_tiles(p.w_out, 1024, 1024, 1024, p.WtO, smem, tid);
}

__device__ void phaseB(const Params& p, int tid) {
  int lane = tid & 63;
  int gw = blockIdx.x * NWV + (tid >> 6);
  int nw = gridDim.x * NWV;
  for (int r = gw; r < LT; r += nw) {
    const float* src = (r < L) ? p.x + (size_t)r * D : p.ctx + (size_t)(r - L) * D;
    const float* md = p.mod + ((r < L) ? 0 : 3072);
    float4 v[4];
    float ss = 0.f;
#pragma unroll
    for (int i = 0; i < 4; ++i) {
      v[i] = *(const float4*)(src + i * 256 + lane * 4);
      ss += v[i].x * v[i].x + v[i].y * v[i].y + v[i].z * v[i].z + v[i].w * v[i].w;
    }
    ss = wsum(ss);
    float inv = rsqrtf(ss * (1.f / D) + EPS);
#pragma unroll
    for (int i = 0; i < 4; ++i) {
      int j = i * 256 + lane * 4;
      float4 g = *(const float4*)(p.g_pre + j);
      float4 sh = *(const float4*)(md + j);
      float4 sc = *(const float4*)(md + 1024 + j);
      float o0 = v[i].x * inv * g.x * (1.f + sc.x) + sh.x;
      float o1 = v[i].y * inv * g.y * (1.f + sc.y) + sh.y;
      float o2 = v[i].z * inv * g.z * (1.f + sc.z) + sh.z;
      float o3 = v[i].w * inv * g.w * (1.f + sc.w) + sh.w;
      __half2 h0 = __floats2half2_rn(o0, o1), h1 = __floats2half2_rn(o2, o3);
      __half2* dst = (__half2*)(p.H + (size_t)r * D + j);
      dst[0] = h0;
      dst[1] = h1;
    }
  }
}

namespace g8 {
constexpr int BM = 256, BK = 64, HALF = 128, NXCD = 8, WGM = 8, HT = HALF * BK;
__device__ __forceinline__ int lds_byte(int r, int c) {
  int st = (r >> 4) * 2 + (c >> 5), rr = r & 15, cc = c & 31, ob = rr * 64 + cc * 2;
  return st * 1024 + (ob ^ (((ob >> 9) & 1) << 5));
}
__device__ __forceinline__ void stage_rc(int b, int& R, int& C) {
  int st = b / 1024, sb = b % 1024, swz = sb ^ (((sb >> 9) & 1) << 5);
  R = (st >> 1) * 16 + swz / 64;
  C = (st & 1) * 32 + (swz % 64) / 2;
}
}

template <class Epi>
__device__ void gemm_mfma(const __half* __restrict__ A, const __half* __restrict__ Bt, int M, int N, __half* shm,
                          int tid, Epi epi) {
  using namespace g8;
  constexpr int KK = 1024;
  const int sb0 = tid * 16, sb1 = sb0 + 8192;
  int vo0, vo1;
  {
    int r0, c0, r1, c1;
    stage_rc(sb0, r0, c0);
    stage_rc(sb1, r1, c1);
    vo0 = r0 * KK + c0;
    vo1 = r1 * KK + c1;
  }
#define SA(b, h) (shm + ((b)*2 + (h)) * HT)
#define SB(b, h) (shm + (4 + (b)*2 + (h)) * HT)
#define STAGE(P, BASE, br, kt)                                                                             \
  do {                                                                                                     \
    const __half* _gb = (BASE) + (long)(br)*KK + (long)(kt)*BK;                                            \
    __builtin_amdgcn_global_load_lds((const unsigned*)(_gb + vo0),                                         \
                                     (__attribute__((address_space(3))) unsigned*)((char*)(P) + sb0), 16, 0, 0); \
    __builtin_amdgcn_global_load_lds((const unsigned*)(_gb + vo1),                                         \
                                     (__attribute__((address_space(3))) unsigned*)((char*)(P) + sb1), 16, 0, 0); \
  } while (0)
#define LDA(dst, b, h)                                                                                     \
  for (int m = 0; m < 4; ++m)                                                                              \
    for (int k = 0; k < 2; ++k)                                                                            \
  dst[m][k] = *reinterpret_cast<const f16x8*>((char*)SA(b, h) + lds_byte(wr * 64 + m * 16 + fr, k * 32 + fq * 8))
#define LDB(dst, b, h)                                                                                     \
  for (int n = 0; n < 2; ++n)                                                                              \
    for (int k = 0; k < 2; ++k)                                                                            \
  dst[n][k] = *reinterpret_cast<const f16x8*>((char*)SB(b, h) + lds_byte(wc * 32 + n * 16 + fr, k * 32 + fq * 8))
#define MMA(ai, bj, At_, Bt_)                                                                              \
  do {                                                                                                     \
    __builtin_amdgcn_s_setprio(1);                                                                         \
    for (int m = 0; m < 4; ++m)                                                                            \
      for (int n = 0; n < 2; ++n)                                                                          \
        for (int k = 0; k < 2; ++k)                                                                        \
          acc[ai][bj][m][n] =                                                                              \
              __builtin_amdgcn_mfma_f32_16x16x32_f16(Bt_[n][k], At_[m][k], acc[ai][bj][m][n], 0, 0, 0);  \
    __builtin_amdgcn_s_setprio(0);                                                                         \
  } while (0)
#define WAIT_V(n) asm volatile("s_waitcnt vmcnt(" #n ")" ::: "memory")
#define WAIT_L(n) asm volatile("s_waitcnt lgkmcnt(" #n ")" ::: "memory")
#define BAR __builtin_amdgcn_s_barrier()
#define SCHED __builtin_amdgcn_sched_barrier(0)
  const int nM = M / BM, nN = N / BM, nwg = nM * nN;
  const int wid = tid >> 6, lane = tid & 63, wr = wid >> 2, wc = wid & 3, fr = lane & 15, fq = lane >> 4;
  constexpr int nt = KK / BK;
  for (int tile = blockIdx.x; tile < nwg; tile += gridDim.x) {
    int wgid = tile;
    {
      int q = nwg / NXCD, r = nwg % NXCD, xcd = wgid % NXCD, off = wgid / NXCD;
      wgid = (xcd < r ? xcd * (q + 1) : r * (q + 1) + (xcd - r) * q) + off;
    }
    int nig = WGM * nN, gid = wgid / nig, fm = gid * WGM, gsz = min(nM - fm, WGM);
    int pm = fm + ((wgid % nig) % gsz), pn = (wgid % nig) / gsz, brow = pm * BM, bcol = pn * BM;
    f32x4 acc[2][2][4][2] = {};
    f16x8 At[4][2], B0[2][2], B1[2][2];
    STAGE(SB(0, 0), Bt, bcol, 0);
    STAGE(SA(0, 0), A, brow, 0);
    STAGE(SB(0, 1), Bt, bcol + HALF, 0);
    STAGE(SA(0, 1), A, brow + HALF, 0);
    if (wr == 1) BAR;
    WAIT_V(4);
    BAR;
    STAGE(SB(1, 0), Bt, bcol, 1);
    STAGE(SA(1, 0), A, brow, 1);
    STAGE(SB(1, 1), Bt, bcol + HALF, 1);
    WAIT_V(6);
    BAR;
    for (int t = 0; t < nt - 2; t += 2) {
      LDB(B0, 0, 0); SCHED; LDA(At, 0, 0); STAGE(SA(1, 1), A, brow + HALF, t + 1);
      WAIT_L(8); BAR; WAIT_L(0); MMA(0, 0, At, B0); BAR; SCHED;
      LDB(B1, 0, 1); STAGE(SB(0, 0), Bt, bcol, t + 2);
      BAR; WAIT_L(0); MMA(0, 1, At, B1); BAR;
      LDA(At, 0, 1); STAGE(SA(0, 0), A, brow, t + 2);
      BAR; WAIT_L(0); MMA(1, 0, At, B0); BAR; SCHED;
      STAGE(SB(0, 1), Bt, bcol + HALF, t + 2);
      WAIT_V(6); BAR; MMA(1, 1, At, B1); BAR;
      LDB(B0, 1, 0); SCHED; LDA(At, 1, 0); STAGE(SA(0, 1), A, brow + HALF, t + 2);
      WAIT_L(8); BAR; WAIT_L(0); MMA(0, 0, At, B0); BAR; SCHED;
      LDB(B1, 1, 1); STAGE(SB(1, 0), Bt, bcol, t + 3);
      BAR; WAIT_L(0); MMA(0, 1, At, B1); BAR;
      LDA(At, 1, 1); STAGE(SA(1, 0), A, brow, t + 3);
      BAR; WAIT_L(0); MMA(1, 0, At, B0); BAR; SCHED;
      STAGE(SB(1, 1), Bt, bcol + HALF, t + 3);
      WAIT_V(6); BAR; MMA(1, 1, At, B1); BAR;
    }
    {
      LDB(B0, 0, 0); LDA(At, 0, 0); STAGE(SA(1, 1), A, brow + HALF, nt - 1);
      BAR; WAIT_L(0); MMA(0, 0, At, B0); BAR;
      LDB(B1, 0, 1); BAR; WAIT_L(0); MMA(0, 1, At, B1); BAR;
      LDA(At, 0, 1); WAIT_V(4); BAR; WAIT_L(0); MMA(1, 0, At, B0); MMA(1, 1, At, B1); BAR;
    }
    {
      LDB(B0, 1, 0); LDA(At, 1, 0); WAIT_V(2); BAR; WAIT_L(0); MMA(0, 0, At, B0); BAR;
      LDB(B1, 1, 1); WAIT_V(0); BAR; WAIT_L(0); MMA(0, 1, At, B1); BAR;
      LDA(At, 1, 1); BAR; WAIT_L(0); MMA(1, 0, At, B0); MMA(1, 1, At, B1); BAR;
    }
    if (wr == 0) BAR;
    {
      int t2 = tid;
      asm volatile("" : "+v"(t2));
      const int ewid = t2 >> 6, el = t2 & 63, ewr = ewid >> 2, ewc = ewid & 3, efr = el & 15, efq = el >> 4;
      for (int ai = 0; ai < 2; ++ai)
        for (int bj = 0; bj < 2; ++bj)
          for (int m = 0; m < 4; ++m)
            for (int n = 0; n < 2; ++n)
              epi(brow + ai * HALF + ewr * 64 + m * 16 + efr, bcol + bj * HALF + ewc * 32 + n * 16 + efq * 4,
                  acc[ai][bj][m][n]);
    }
  }
#undef SA
#undef SB
#undef STAGE
#undef LDA
#undef LDB
#undef MMA
}

__device__ inline void store_h4(__half* dst, f32x4 v) {
  __half2 h[2] = {__floats2half2_rn(v[0], v[1]), __floats2half2_rn(v[2], v[3])};
  *(uint2*)dst = *(uint2*)h;
}

__device__ void phaseC(const Params& p, __half* shm, int tid) {
  auto epi = [&](int m, int n, f32x4 v) {
    if (n < 2048)
      store_h4(p.NAP + (size_t)m * 2048 + n, v);
    else if (n < 3584)
      store_h4(p.GQ + (size_t)m * 1536 + (n - 2048), v);
    else if (n < 4096)
      store_h4(p.GZ + (size_t)m * 512 + (n - 3584), v);
    else if (n < 4112)
      *(f32x4*)(p.GBA + (size_t)m * 16 + (n - 4096)) = v;
  };
  gemm_mfma(p.H, p.WtI, LT, NPAD, shm, tid, epi);
}

__device__ void phaseD_gdnpre(const Params& p, int tid) {
  int lane = tid & 63;
  int gw = blockIdx.x * NWV + (tid >> 6);
  int nw = gridDim.x * NWV;
  int axis = lane >> 5, fi = lane & 31;
  int d1 = axis * 64 + fi, d2 = d1 + 32;
  float inv_freq = powf(10000.f, -(float)(2 * fi) / 64.f);
  for (int item = gw; item < LT * 12; item += nw) {
    int r = item / 12, grp = item % 12;
    int pos, len, base;
    if (r < L) {
      pos = r; len = L; base = 0;
    } else {
      pos = r - L; len = CTX; base = L;
    }
    int ch1 = grp * 128 + d1, ch2 = grp * 128 + d2;
    float a1 = 0.f, a2 = 0.f;
#pragma unroll
    for (int j = 0; j < 5; ++j) {
      int pp = pos + j - 2;
      if (pp >= 0 && pp < len) {
        const __half* row = p.GQ + (size_t)(base + pp) * 1536;
        a1 += p.conv_w[j * 1536 + ch1] * __half2float(row[ch1]);
        a2 += p.conv_w[j * 1536 + ch2] * __half2float(row[ch2]);
      }
    }
    a1 = siluf(a1);
    a2 = siluf(a2);
    if (grp < 8) {
      float ss = wsum(a1 * a1 + a2 * a2);
      float inv = rsqrtf(ss + EPS);
      a1 *= inv;
      a2 *= inv;
      if (r < L) {
        float posv = (axis == 0) ? (float)(pos / GW) : (float)(pos % GW);
        float ang = posv * inv_freq;
        float cs = cosf(ang), sn = sinf(ang);
        float n1 = a1 * cs - a2 * sn;
        float n2 = a2 * cs + a1 * sn;
        a1 = n1;
        a2 = n2;
      }
    }
    p.QKV[(size_t)r * 1536 + ch1] = __float2half(a1);
    p.QKV[(size_t)r * 1536 + ch2] = __float2half(a2);
    if (grp == 0 && lane < 8) {
      float b = p.GBA[(size_t)r * 16 + lane];
      float a = p.GBA[(size_t)r * 16 + 8 + lane];
      float beta = 1.f / (1.f + __expf(-b));
      float xx = a + p.dt_bias[lane];
      float sp = (xx > 20.f) ? xx : log1pf(expf(xx));
      float g = -expf(p.A_log[lane]) * sp;
      p.BETA[(size_t)r * 8 + lane] = beta;
      p.GG[(size_t)r * 8 + lane] = g;
    }
  }
}

__device__ void phaseD_na(const Params& p, float* smem, int tid) {
  int lane = tid & 63, w = tid >> 6;
  int gw = blockIdx.x * NWV + w;
  int nw = gridDim.x * NWV;
  float* qs = smem + w * 512;
  float* ps = smem + w * 512 + 64;
  for (int item = gw; item < L * 8; item += nw) {
    int t = item >> 3, h = item & 7;
    int r = t / GW, c = t % GW;
    int rs = min(max(r - 4, 0), 256 - 8);
    int cs = min(max(c - 8, 0), GW - 16);
    qs[lane] = __half2float(p.NAP[(size_t)t * 2048 + h * 64 + lane]) * 0.125f;
    __builtin_amdgcn_wave_barrier();
    __builtin_amdgcn_s_waitcnt(0xc07f);
    float s[6];
#pragma unroll
    for (int kk = 0; kk < 6; ++kk) {
      int kidx = lane + 64 * kk;
      int tok;
      float bias = 0.f;
      if (kk < 2) {
        int i = kidx >> 4, j = kidx & 15;
        tok = (rs + i) * GW + cs + j;
        bias = p.rpb[h * (15 * 31) + (rs + i - r + 7) * 31 + (cs + j - c + 15)];
      } else {
        tok = L + (kidx - 128);
      }
      const uint4* kp = (const uint4*)(p.NAP + (size_t)tok * 2048 + 512 + h * 64);
      float dot = 0.f;
#pragma unroll
      for (int u = 0; u < 8; ++u) {
        uint4 kv = kp[u];
        const __half2* h2 = (const __half2*)&kv;
#pragma unroll
        for (int e = 0; e < 4; ++e) {
          float2 f = __half22float2(h2[e]);
          dot += f.x * qs[u * 8 + e * 2] + f.y * qs[u * 8 + e * 2 + 1];
        }
      }
      s[kk] = dot + bias;
    }
    float m = s[0];
#pragma unroll
    for (int kk = 1; kk < 6; ++kk) m = fmaxf(m, s[kk]);
    m = wmax(m);
    float sum = 0.f;
#pragma unroll
    for (int kk = 0; kk < 6; ++kk) {
      s[kk] = __expf(s[kk] - m);
      sum += s[kk];
    }
    sum = wsum(sum);
    float rinv = 1.f / sum;
#pragma unroll
    for (int kk = 0; kk < 6; ++kk) ps[lane + 64 * kk] = s[kk] * rinv;
    __builtin_amdgcn_wave_barrier();
    __builtin_amdgcn_s_waitcnt(0xc07f);
    float o = 0.f;
    for (int key = 0; key < 128; ++key) {
      int i = key >> 4, j = key & 15;
      int tok = (rs + i) * GW + cs + j;
      o += ps[key] * __half2float(p.NAP[(size_t)tok * 2048 + 1024 + h * 64 + lane]);
    }
    for (int key = 0; key < 256; ++key) {
      o += ps[128 + key] * __half2float(p.NAP[(size_t)(L + key) * 2048 + 1024 + h * 64 + lane]);
    }
    float z = __half2float(p.NAP[(size_t)t * 2048 + 1536 + h * 64 + lane]);
    p.MIX[(size_t)t * 1024 + h * 64 + lane] = __float2half(o * siluf(z));
    __builtin_amdgcn_wave_barrier();
  }
}

__device__ inline int seqrow(int dir, int n) {
  if (dir == 0) return (n < CTX) ? (L + n) : (n - CTX);
  return (n < CTX) ? (L + CTX - 1 - n) : (L - 1 - (n - CTX));
}
constexpr int NCH = LT / 64;
#define MFMA16(a, b, c) __builtin_amdgcn_mfma_f32_16x16x32_f16(a, b, c, 0, 0, 0)

__device__ void phaseE1(const Params& p, float* smem, int tid) {
  const int lane = tid & 63, w = tid >> 6, fr = lane & 15, fq = lane >> 4;
  float* Am = smem + w * 4096;
  float* gs = smem + 8 * 4096 + w * 128;
  const float scale = 0.08838834764831845f;
  for (int item = blockIdx.x * NWV + w; item < 8 * NCH; item += gridDim.x * NWV) {
    const int chain = item / NCH, n = item % NCH;
    const int dir = chain >> 2, hd = chain & 3;
    const int row_s = seqrow(dir, n * 64 + lane);
    const float g = p.GG[(size_t)row_s * 8 + dir * 4 + hd], beta = p.BETA[(size_t)row_s * 8 + dir * 4 + hd];
    float gc = g;
#pragma unroll
    for (int o = 1; o < 64; o <<= 1) {
      float t = __shfl_up(gc, o, 64);
      if (lane >= o) gc += t;
    }
    const float gl = __shfl(gc, 63, 64);
    {
      const float e = __expf(gc);
      float* sc = p.SC + (size_t)item * 320;
      sc[lane] = beta * e;
      sc[64 + lane] = __expf(gl - gc);
      sc[128 + lane] = scale * e;
      sc[192 + lane] = beta;
      if (lane == 0) sc[256] = __expf(gl);
    }
    gs[lane] = gc;
    gs[64 + lane] = beta;
    f16x8 kf[4][4];
    auto loadk = [&]() {
#pragma unroll
      for (int m = 0; m < 4; ++m) {
        const int row = seqrow(dir, n * 64 + 16 * m + fr);
        const __half* base = p.QKV + (size_t)row * 1536 + 512 + hd * 128 + 8 * fq;
#pragma unroll
        for (int kk = 0; kk < 4; ++kk) kf[m][kk] = *(const f16x8*)(base + 32 * kk);
      }
    };
    loadk();
    __builtin_amdgcn_wave_barrier();
#pragma unroll
    for (int mi = 0; mi < 4; ++mi) {
      const f32x4 gci = *(const f32x4*)(gs + 16 * mi + 4 * fq);
      const f32x4 bti = *(const f32x4*)(gs + 64 + 16 * mi + 4 * fq);
#pragma unroll
      for (int nj = 0; nj <= mi; ++nj) {
        f32x4 acc = {0.f, 0.f, 0.f, 0.f};
#pragma unroll
        for (int kk = 0; kk < 4; ++kk) acc = MFMA16(kf[mi][kk], kf[nj][kk], acc);
        const int j = 16 * nj + fr;
        const float gcj = gs[j];
#pragma unroll
        for (int r = 0; r < 4; ++r) {
          const int i = 16 * mi + 4 * fq + r;
          float val = bti[r] * acc[r] * __expf(fminf(gci[r] - gcj, 0.f));
          Am[i * 64 + j] = (i > j) ? val : 0.f;
        }
      }
    }
    __builtin_amdgcn_wave_barrier();
    float Tc[64];
    int lane_i = lane;
    asm volatile("" : "+v"(lane_i));
#pragma unroll
    for (int i = 0; i < 64; ++i) {
      float s = (i == lane_i) ? 1.f : 0.f;
#pragma unroll
      for (int j = 0; j < i; ++j) s -= Am[i * 64 + j] * Tc[j];
      Tc[i] = s;
    }
    {
      __half* Tb = p.TB + (size_t)item * 4096;
#pragma unroll
      for (int i = 0; i < 64; ++i) Tb[i * 64 + lane] = __float2half(Tc[i]);
    }
    asm volatile("" ::: "memory");
    loadk();
    __half* Qb = p.QKM + (size_t)item * 4096;
#pragma unroll
    for (int mi = 0; mi < 4; ++mi) {
      f16x8 qf[4];
      {
        const int row = seqrow(dir, n * 64 + 16 * mi + fr);
        const __half* base = p.QKV + (size_t)row * 1536 + hd * 128 + 8 * fq;
#pragma unroll
        for (int kk = 0; kk < 4; ++kk) qf[kk] = *(const f16x8*)(base + 32 * kk);
      }
      const int i = 16 * mi + fr;
      const float gci = gs[i];
#pragma unroll
      for (int nj = 0; nj < 4; ++nj) {
        f32x4 acc = {0.f, 0.f, 0.f, 0.f};
        if (nj <= mi) {
#pragma unroll
          for (int kk = 0; kk < 4; ++kk) acc = MFMA16(kf[nj][kk], qf[kk], acc);
          const f32x4 gcj = *(const f32x4*)(gs + 16 * nj + 4 * fq);
#pragma unroll
          for (int r = 0; r < 4; ++r) {
            const int j = 16 * nj + 4 * fq + r;
            float val = acc[r] * scale * __expf(fminf(gci - gcj[r], 0.f));
            acc[r] = (i >= j) ? val : 0.f;
          }
        }
        store_h4(Qb + i * 64 + 16 * nj + 4 * fq, acc);
      }
    }
    __builtin_amdgcn_wave_barrier();
  }
}

__device__ void phaseE2(const Params& p, float* smem, int tid) {
  if (blockIdx.x >= 64) return;
  const int chain = blockIdx.x >> 3, slice = blockIdx.x & 7, dir = chain >> 2, hd = chain & 3, e0 = slice * 16;
  const int lane = tid & 63, w = tid >> 6, fr = lane & 15, fq = lane >> 4;
  const bool roleA = (w < 4);
  const int mt = w & 3;
  char* lds = (char*)smem;
  __half* klds = (__half*)lds;
  __half* ST = (__half*)(lds + 34816);
  __half* rhsT = (__half*)(lds + 34816 + 4352);
  __half* vnT = rhsT + 16 * 72;
  __half* vndT = vnT + 16 * 72;
  float* scl = (float*)(lds + 34816 + 4352 + 3 * 2304);
  __half* Od = dir ? p.OB : p.OF;

  f32x4 Sacc = {0.f, 0.f, 0.f, 0.f};
  for (int i = tid; i < 16 * 136; i += NT) ST[i] = __float2half(0.f);

  uint4 kst0 = {0, 0, 0, 0}, kst1 = {0, 0, 0, 0};
  f16x8 pa[4] = {}, pb[2] = {};
  f16x4 pv = {0, 0, 0, 0};
  float4 sc4 = {0.f, 0.f, 0.f, 0.f};
  f16x8 ca[4], cb[2];
  f16x4 cv = {0, 0, 0, 0};

  auto issue = [&](int n) {
    const size_t item = (size_t)chain * NCH + n;
    {
      const int pos = tid >> 4, c16 = tid & 15;
      kst0 = *(const uint4*)(p.QKV + (size_t)seqrow(dir, n * 64 + pos) * 1536 + 512 + hd * 128 + c16 * 8);
      kst1 = *(const uint4*)(p.QKV + (size_t)seqrow(dir, n * 64 + pos + 32) * 1536 + 512 + hd * 128 + c16 * 8);
    }
    if (roleA) {
      const __half* tb = p.TB + item * 4096 + (16 * mt + fr) * 64 + 8 * fq;
      pa[0] = *(const f16x8*)(tb);
      pa[1] = *(const f16x8*)(tb + 32);
#pragma unroll
      for (int r = 0; r < 4; ++r) {
        const int row = seqrow(dir, n * 64 + 16 * mt + 4 * fq + r);
        pv[r] = ((const _Float16*)p.QKV)[(size_t)row * 1536 + 1024 + hd * 128 + e0 + fr];
      }
    } else {
      const int row = seqrow(dir, n * 64 + 16 * mt + fr);
      const __half* qb = p.QKV + (size_t)row * 1536 + hd * 128 + 8 * fq;
#pragma unroll
      for (int kk = 0; kk < 4; ++kk) pa[kk] = *(const f16x8*)(qb + 32 * kk);
      const __half* kb = p.QKM + item * 4096 + (16 * mt + fr) * 64 + 8 * fq;
      pb[0] = *(const f16x8*)(kb);
      pb[1] = *(const f16x8*)(kb + 32);
    }
    if (tid < 80) sc4 = *(const float4*)(p.SC + item * 320 + tid * 4);
  };
  auto stash = [&](int n) {
    __half* kd = klds + (n & 1) * (64 * 136);
    {
      const int pos = tid >> 4, c16 = tid & 15;
      *(uint4*)(kd + pos * 136 + c16 * 8) = kst0;
      *(uint4*)(kd + (pos + 32) * 136 + c16 * 8) = kst1;
    }
    if (tid < 80) *(float4*)(scl + (n & 1) * 320 + tid * 4) = sc4;
  };
  auto rotate = [&]() {
#pragma unroll
    for (int i = 0; i < 4; ++i) ca[i] = pa[i];
    cb[0] = pb[0];
    cb[1] = pb[1];
    cv = pv;
  };

  issue(0);
  stash(0);
  rotate();
  __syncthreads();

  for (int n = 0; n < NCH; ++n) {
    if (n + 1 < NCH) issue(n + 1);
    const __half* kc = klds + (n & 1) * (64 * 136);
    const float* sc = scl + (n & 1) * 320;
    f16x8 Sf[4];
#pragma unroll
    for (int kk = 0; kk < 4; ++kk) Sf[kk] = *(const f16x8*)(ST + fr * 136 + 32 * kk + 8 * fq);
    f32x4 acc = {0.f, 0.f, 0.f, 0.f};
    if (roleA) {
#pragma unroll
      for (int kk = 0; kk < 4; ++kk) {
        f16x8 kfr = *(const f16x8*)(kc + (16 * mt + fr) * 136 + 32 * kk + 8 * fq);
        acc = MFMA16(kfr, Sf[kk], acc);
      }
      const f32x4 be = *(const f32x4*)(sc + 16 * mt + 4 * fq);
      const f32x4 bt = *(const f32x4*)(sc + 192 + 16 * mt + 4 * fq);
      f32x4 rhs;
#pragma unroll
      for (int r = 0; r < 4; ++r) rhs[r] = bt[r] * (float)cv[r] - be[r] * acc[r];
      store_h4(rhsT + fr * 72 + 16 * mt + 4 * fq, rhs);
    } else {
#pragma unroll
      for (int kk = 0; kk < 4; ++kk) acc = MFMA16(ca[kk], Sf[kk], acc);
    }
    __syncthreads();
    if (roleA) {
      f32x4 vn = {0.f, 0.f, 0.f, 0.f};
#pragma unroll
      for (int kk = 0; kk < 2; ++kk) {
        f16x8 rf = *(const f16x8*)(rhsT + fr * 72 + 32 * kk + 8 * fq);
        vn = MFMA16(ca[kk], rf, vn);
      }
      const f32x4 dd = *(const f32x4*)(sc + 64 + 16 * mt + 4 * fq);
      store_h4(vnT + fr * 72 + 16 * mt + 4 * fq, vn);
      f32x4 vd;
#pragma unroll
      for (int r = 0; r < 4; ++r) vd[r] = vn[r] * dd[r];
      store_h4(vndT + fr * 72 + 16 * mt + 4 * fq, vd);
    }
    __syncthreads();
    if (!roleA) {
      const f32x4 se = *(const f32x4*)(sc + 128 + 16 * mt + 4 * fq);
      f32x4 o;
#pragma unroll
      for (int r = 0; r < 4; ++r) o[r] = se[r] * acc[r];
#pragma unroll
      for (int kk = 0; kk < 2; ++kk) {
        f16x8 vf = *(const f16x8*)(vnT + fr * 72 + 32 * kk + 8 * fq);
        o = MFMA16(cb[kk], vf, o);
      }
      if (n >= 4) {
#pragma unroll
        for (int r = 0; r < 4; ++r) {
          const int row = seqrow(dir, n * 64 + 16 * mt + 4 * fq + r);
          Od[(size_t)row * 512 + hd * 128 + e0 + fr] = __float2half(o[r]);
        }
      }
    }
    {
      const float glast = sc[256];
#pragma unroll
      for (int r = 0; r < 4; ++r) Sacc[r] *= glast;
#pragma unroll
      for (int kk = 0; kk < 2; ++kk) {
        f16x8 vdf = *(const f16x8*)(vndT + fr * 72 + 32 * kk + 8 * fq);
        f16x8 ktf;
#pragma unroll
        for (int j = 0; j < 8; ++j) {
          ktf[j] = ((const _Float16*)kc)[(32 * kk + 8 * fq + j) * 136 + 16 * w + fr];
        }
        Sacc = MFMA16(ktf, vdf, Sacc);
      }
      store_h4(ST + fr * 136 + 16 * w + 4 * fq, Sacc);
    }
    if (n + 1 < NCH) {
      stash(n + 1);
      rotate();
    }
    __syncthreads();
  }
}

__device__ void phaseF(const Params& p, int tid) {
  int lane = tid & 63;
  int gw = blockIdx.x * NWV + (tid >> 6);
  int nw = gridDim.x * NWV;
  for (int item = gw; item < L * 4; item += nw) {
    int t = item >> 2, h = item & 3;
    size_t o = (size_t)t * 512 + h * 128;
    float v1 = __half2float(p.OF[o + lane]) + __half2float(p.OB[o + lane]);
    float v2 = __half2float(p.OF[o + lane + 64]) + __half2float(p.OB[o + lane + 64]);
    float ss = wsum(v1 * v1 + v2 * v2);
    float inv = rsqrtf(ss * (1.f / 128.f) + EPS);
    float z1 = __half2float(p.GZ[o + lane]), z2 = __half2float(p.GZ[o + lane + 64]);
    p.MIX[(size_t)t * 1024 + 512 + h * 128 + lane] = __float2half(v1 * inv * p.gdn_norm_w[lane] * siluf(z1));
    p.MIX[(size_t)t * 1024 + 512 + h * 128 + lane + 64] =
        __float2half(v2 * inv * p.gdn_norm_w[lane + 64] * siluf(z2));
  }
}

__device__ void phaseG(const Params& p, __half* shm, int tid) {
  auto epi = [&](int m, int n, f32x4 v) { *(f32x4*)(p.Y + (size_t)m * 1024 + n) = v; };
  gemm_mfma(p.MIX, p.WtO, L, 1024, shm, tid, epi);
}

__device__ void phaseH(const Params& p, int tid) {
  int lane = tid & 63;
  int gw = blockIdx.x * NWV + (tid >> 6);
  int nw = gridDim.x * NWV;
  for (int r = gw; r < L; r += nw) {
    const float* src = p.Y + (size_t)r * D;
    float4 v[4];
    float ss = 0.f;
#pragma unroll
    for (int i = 0; i < 4; ++i) {
      v[i] = *(const float4*)(src + i * 256 + lane * 4);
      ss += v[i].x * v[i].x + v[i].y * v[i].y + v[i].z * v[i].z + v[i].w * v[i].w;
    }
    ss = wsum(ss);
    float inv = rsqrtf(ss * (1.f / D) + EPS);
#pragma unroll
    for (int i = 0; i < 4; ++i) {
      int j = i * 256 + lane * 4;
      float4 g = *(const float4*)(p.g_post + j);
      float4 gt = *(const float4*)(p.mod + 2048 + j);
      float4 xv = *(const float4*)(p.x + (size_t)r * D + j);
      float4 o;
      o.x = xv.x + gt.x * (v[i].x * inv * g.x);
      o.y = xv.y + gt.y * (v[i].y * inv * g.y);
      o.z = xv.z + gt.z * (v[i].z * inv * g.z);
      o.w = xv.w + gt.w * (v[i].w * inv * g.w);
      *(float4*)(p.out + (size_t)r * D + j) = o;
    }
  }
}

__device__ __forceinline__ int fresh_tid(int wave_s) {
  int lane;
  asm volatile("v_mbcnt_lo_u32_b32 %0, -1, 0\n\tv_mbcnt_hi_u32_b32 %0, -1, %0" : "=v"(lane));
  return wave_s * 64 + lane;
}

template <int PH>
__device__ void run_phase(const Params& p, float* smem, int wave_s) {
  const int tid = fresh_tid(wave_s);
  if constexpr (PH == 0) phaseA(p, smem, tid);
  if constexpr (PH == 1) phaseB(p, tid);
  if constexpr (PH == 2) phaseC(p, (__half*)smem, tid);
  if constexpr (PH == 3) {
    phaseD_gdnpre(p, tid);
    phaseD_na(p, smem, tid);
  }
  if constexpr (PH == 4) phaseE1(p, smem, tid);
  if constexpr (PH == 8) phaseE2(p, smem, tid);
  if constexpr (PH == 5) phaseF(p, tid);
  if constexpr (PH == 6) phaseG(p, (__half*)smem, tid);
  if constexpr (PH == 7) phaseH(p, tid);
}

__global__ void __launch_bounds__(NT, 2) mega(Params p) {
  extern __shared__ __attribute__((aligned(16))) float smem[];
  cg::grid_group grid = cg::this_grid();
  const int wave_s = __builtin_amdgcn_readfirstlane((int)(hipThreadIdx_x >> 6));
  run_phase<0>(p, smem, wave_s); grid.sync();
  run_phase<1>(p, smem, wave_s); grid.sync();
  run_phase<2>(p, smem, wave_s); grid.sync();
  run_phase<3>(p, smem, wave_s); grid.sync();
  run_phase<4>(p, smem, wave_s); grid.sync();
  run_phase<8>(p, smem, wave_s); grid.sync();
  run_phase<5>(p, smem, wave_s); grid.sync();
  run_phase<6>(p, smem, wave_s); grid.sync();
  run_phase<7>(p, smem, wave_s);
}

extern "C" void kernel_launch(void* const* d_in, const int* in_sizes, int n_in, void* d_out, int out_size, void* d_ws,
                              size_t ws_size, hipStream_t stream) {
  Params p{};
  p.x = (const float*)d_in[0];
  p.c = (const float*)d_in[1];
  p.ctx = (const float*)d_in[2];
  p.c_ctx = (const float*)d_in[3];
  p.w_ada = (const float*)d_in[4];
  p.b_ada = (const float*)d_in[5];
  p.g_pre = (const float*)d_in[6];
  p.g_post = (const float*)d_in[7];
  p.w_in = (const float*)d_in[8];
  p.conv_w = (const float*)d_in[9];
  p.rpb = (const float*)d_in[10];
  p.A_log = (const float*)d_in[11];
  p.dt_bias = (const float*)d_in[12];
  p.gdn_norm_w = (const float*)d_in[13];
  p.w_out = (const float*)d_in[14];
  p.out = (float*)d_out;
  char* ws = (char*)d_ws;
  size_t off = 0;
  auto take = [&](size_t bytes) {
    char* q = ws + off;
    off += (bytes + 255) & ~(size_t)255;
    return q;
  };
  p.mod = (float*)take(2 * 3072 * 4);
  p.WtI = (__half*)take((size_t)NPAD * 1024 * 2);
  p.WtO = (__half*)take((size_t)1024 * 1024 * 2);
  p.H = (__half*)take((size_t)LT * 1024 * 2);
  p.MIX = p.H;
  p.NAP = (__half*)take((size_t)LT * 2048 * 2);
  p.Y = (float*)p.NAP;
  p.GQ = (__half*)take((size_t)LT * 1536 * 2);
  p.OF = p.GQ;
  p.OB = p.GQ + (size_t)L * 512;
  p.TB = p.GQ + (size_t)2 * L * 512;
  p.GZ = (__half*)take((size_t)LT * 512 * 2);
  p.GBA = (float*)take((size_t)LT * 16 * 4);
  p.QKV = (__half*)take((size_t)LT * 1536 * 2);
  p.BETA = (float*)take((size_t)LT * 8 * 4);
  p.GG = (float*)take((size_t)LT * 8 * 4);
  p.QKM = (__half*)take((size_t)8 * 260 * 4096 * 2);
  p.SC = (float*)take((size_t)8 * 260 * 320 * 4);

  static int grid_blocks = 0;
  if (!grid_blocks) {
    int dev = 0, cus = 0, per_cu = 0;
    (void)hipGetDevice(&dev);
    (void)hipDeviceGetAttribute(&cus, hipDeviceAttributeMultiprocessorCount, dev);
    (void)hipFuncSetAttribute((const void*)mega, hipFuncAttributeMaxDynamicSharedMemorySize, LDS_BYTES);
    (void)hipOccupancyMaxActiveBlocksPerMultiprocessor(&per_cu, mega, NT, LDS_BYTES);
    if (per_cu < 1) per_cu = 1;
    grid_blocks = cus * per_cu;
  }
  void* args[] = {&p};
  hipError_t e = hipLaunchCooperativeKernel((void*)mega, dim3(grid_blocks), dim3(NT), args, LDS_BYTES, stream);
  if (e != hipSuccess) fprintf(stderr, "cooperative launch failed: %s (grid %d)\n", hipGetErrorString(e), grid_blocks);
}

#ifdef DIAG_PHASES
template <int PH>
__global__ void __launch_bounds__(NT, 2) phase_k(Params p) {
  extern __shared__ __attribute__((aligned(16))) float smem[];
  run_phase<PH>(p, smem, (int)(hipThreadIdx_x >> 6));
}
template __global__ void phase_k<2>(Params);
template __global__ void phase_k<3>(Params);
template __global__ void phase_k<4>(Params);
template __global__ void phase_k<8>(Params);
template __global__ void phase_k<6>(Params);
#endif
```

```cpp
#include <hip/hip_runtime.h>
#include <hip/hip_fp16.h>
#include <hip/hip_cooperative_groups.h>
#include <cstdio>
namespace cg = cooperative_groups;

#ifndef MK_MULTI
#define MK_MULTI 0
#endif

constexpr int L = 16384, CTX = 256, LT = L + CTX, D = 1024, IN_DIM = 4112;
constexpr int NT = 512, NWV = NT / 64;
constexpr int NPAD = 4352;
constexpr int LDS_BYTES = 147456;
typedef _Float16 f16x8 __attribute__((ext_vector_type(8)));
typedef _Float16 f16x4 __attribute__((ext_vector_type(4)));
typedef __fp16 h16x4 __attribute__((__vector_size__(4 * sizeof(__fp16))));
typedef float f32x4 __attribute__((ext_vector_type(4)));
constexpr int GW = 64;
constexpr float EPS = 1e-6f;

struct Params {
  const float *x, *c, *ctx, *c_ctx, *w_ada, *b_ada, *g_pre, *g_post, *w_in, *conv_w, *rpb, *A_log, *dt_bias,
      *gdn_norm_w, *w_out;
  float* out;
  float* mod;
  __half* WtI;
  __half* WtO;
  __half* H;
  __half* NAP;
  __half* VT;
  __half* GQ;
  __half* GZ;
  float* GBA;
  __half* QKV;
  float* BETA;
  float* GG;
  __half* TB;
  __half* QKM;
  float* SC;
  unsigned* E1DONE;
  float* ROPE;
  __half* OF;
  __half* OB;
  __half* MIX;
  __half* Y;
};

__device__ inline float wsum(float v) {
#pragma unroll
  for (int o = 32; o > 0; o >>= 1) v += __shfl_xor(v, o, 64);
  return v;
}
__device__ inline float wmax(float v) {
#pragma unroll
  for (int o = 32; o > 0; o >>= 1) v = fmaxf(v, __shfl_xor(v, o, 64));
  return v;
}
__device__ inline void store_h4(__half* dst, f32x4 v) {
  __half2 h[2] = {__floats2half2_rn(v[0], v[1]), __floats2half2_rn(v[2], v[3])};
  *(uint2*)dst = *(uint2*)h;
}

__device__ inline float siluf(float x) { return x * __builtin_amdgcn_rcpf(1.f + __expf(-x)); }

__device__ void transpose_tiles(const float* W, int ld, int Nvalid, int Npad, __half* Wt, float* smem, int tid, int b0,
                                int nb) {
  const int tn = Npad / 64, ntile = 16 * tn;
  const int kk0 = tid >> 4, n4 = (tid & 15) * 4;
  auto fetch = [&](int tile, float4& v0, float4& v1) {
    const int tk = tile / tn, tc = tile % tn;
    const int col = tc * 64 + n4;
    const float* src = W + (size_t)(tk * 64 + kk0) * ld + col;
    const bool ok = (tile < ntile) && (col < Nvalid);
    v0 = ok ? *(const float4*)src : make_float4(0.f, 0.f, 0.f, 0.f);
    v1 = ok ? *(const float4*)(src + (size_t)32 * ld) : make_float4(0.f, 0.f, 0.f, 0.f);
  };
  float4 c0, c1, x0, x1;
  int tile = (int)blockIdx.x - b0;
  fetch(tile, c0, c1);
  for (; tile < ntile; tile += nb) {
    fetch(tile + nb, x0, x1);
    const int tk = tile / tn, tc = tile % tn;
    __syncthreads();
    smem[kk0 * 65 + n4 + 0] = c0.x; smem[kk0 * 65 + n4 + 1] = c0.y; smem[kk0 * 65 + n4 + 2] = c0.z; smem[kk0 * 65 + n4 + 3] = c0.w;
    smem[(kk0 + 32) * 65 + n4 + 0] = c1.x; smem[(kk0 + 32) * 65 + n4 + 1] = c1.y;
    smem[(kk0 + 32) * 65 + n4 + 2] = c1.z; smem[(kk0 + 32) * 65 + n4 + 3] = c1.w;
    __syncthreads();
    {
      int nn = tid >> 3, k8 = (tid & 7) * 8;
      __half2 h[4];
#pragma unroll
      for (int i = 0; i < 4; ++i)
        h[i] = __floats2half2_rn(smem[(k8 + 2 * i) * 65 + nn], smem[(k8 + 2 * i + 1) * 65 + nn]);
      *(uint4*)(Wt + (size_t)(tc * 64 + nn) * 1024 + tk * 64 + k8) = *(uint4*)h;
    }
    c0 = x0;
    c1 = x1;
  }
}

__device__ void phaseA(const Params& p, float* smem, int tid) {
  int lane = tid & 63, w = tid >> 6;
  for (int item = blockIdx.x; item < 48; item += gridDim.x) {
    int j = item * 64 + lane;
    float a0 = 0.f, a1 = 0.f;
    int k0 = w * 128;
#pragma unroll 8
    for (int k = k0; k < k0 + 128; ++k) {
      float wv = p.w_ada[(size_t)k * 3072 + j];
      a0 += siluf(p.c[k]) * wv;
      a1 += siluf(p.c_ctx[k]) * wv;
    }
    __syncthreads();
    smem[(w * 2 + 0) * 64 + lane] = a0;
    smem[(w * 2 + 1) * 64 + lane] = a1;
    __syncthreads();
    if (w < 2) {
      float s = 0.f;
#pragma unroll
      for (int ww = 0; ww < NWV; ++ww) s += smem[(ww * 2 + w) * 64 + lane];
      p.mod[w * 3072 + j] = s + p.b_ada[j];
    }
  }
  for (int i = blockIdx.x * NT + tid; i < 320 * 32; i += gridDim.x * NT) {
    const int tr = i >> 5, fi = i & 31;
    const float posv = (float)((tr < 256) ? tr : tr - 256);
    const float ang = posv * powf(10000.f, -(float)(2 * fi) / 64.f);
    p.ROPE[2 * i] = cosf(ang);
    p.ROPE[2 * i + 1] = sinf(ang);
  }
  const int b0 = (gridDim.x > 96) ? 48 : 0, nb = gridDim.x - b0;
  if ((int)blockIdx.x >= b0) {
    transpose_tiles(p.w_in, IN_DIM, IN_DIM, NPAD, p.WtI, smem, tid, b0, nb);
    transpose_tiles(p.w_out, 1024, 1024, 1024, p.WtO, smem, tid, b0, nb);
  }
}

__device__ void phaseB(const Params& p, int tid) {
  int lane = tid & 63;
  int gw = blockIdx.x * NWV + (tid >> 6);
  int nw = gridDim.x * NWV;
  float4 fa[4], fb[4];
  auto factors = [&](const float* md) {
#pragma unroll
    for (int i = 0; i < 4; ++i) {
      const int j = i * 256 + lane * 4;
      const float4 g = *(const float4*)(p.g_pre + j), sh = *(const float4*)(md + j), sc = *(const float4*)(md + 1024 + j);
      fa[i] = make_float4(g.x * (1.f + sc.x), g.y * (1.f + sc.y), g.z * (1.f + sc.z), g.w * (1.f + sc.w));
      fb[i] = sh;
    }
  };
  factors(p.mod);
  bool ctx_f = false;
  for (int r0 = gw; r0 < LT; r0 += 2 * nw) {
    float4 v[2][4];
#pragma unroll
    for (int u = 0; u < 2; ++u) {
      const int r = min(r0 + u * nw, LT - 1);
      const float* src = (r < L) ? p.x + (size_t)r * D : p.ctx + (size_t)(r - L) * D;
#pragma unroll
      for (int i = 0; i < 4; ++i) v[u][i] = *(const float4*)(src + i * 256 + lane * 4);
    }
#pragma unroll
    for (int u = 0; u < 2; ++u) {
      const int r = r0 + u * nw;
      if (r >= LT) break;
      if (r >= L && !ctx_f) {
        factors(p.mod + 3072);
        ctx_f = true;
      }
      float ss = 0.f;
#pragma unroll
      for (int i = 0; i < 4; ++i) ss += v[u][i].x * v[u][i].x + v[u][i].y * v[u][i].y + v[u][i].z * v[u][i].z + v[u][i].w * v[u][i].w;
      ss = wsum(ss);
      const float inv = rsqrtf(ss * (1.f / D) + EPS);
#pragma unroll
      for (int i = 0; i < 4; ++i) {
        const int j = i * 256 + lane * 4;
        const float o0 = v[u][i].x * inv * fa[i].x + fb[i].x;
        const float o1 = v[u][i].y * inv * fa[i].y + fb[i].y;
        const float o2 = v[u][i].z * inv * fa[i].z + fb[i].z;
        const float o3 = v[u][i].w * inv * fa[i].w + fb[i].w;
        __half2 h[2] = {__floats2half2_rn(o0, o1), __floats2half2_rn(o2, o3)};
        *(uint2*)(p.H + (size_t)r * D + j) = *(uint2*)h;
      }
    }
  }
}

namespace g8 {
constexpr int BM = 256, BK = 64, HALF = 128, NXCD = 8, WGM = 8, HT = HALF * BK;
__device__ __forceinline__ int lds_byte(int r, int c) {
  int st = (r >> 4) * 2 + (c >> 5), rr = r & 15, cc = c & 31, ob = rr * 64 + cc * 2;
  return st * 1024 + (ob ^ (((ob >> 9) & 1) << 5));
}
__device__ __forceinline__ void stage_rc(int b, int& R, int& C) {
  int st = b / 1024, sb = b % 1024, swz = sb ^ (((sb >> 9) & 1) << 5);
  R = (st >> 1) * 16 + swz / 64;
  C = (st & 1) * 32 + (swz % 64) / 2;
}
}

template <class Epi>
__device__ void gemm_mfma(const __half* __restrict__ A, const __half* __restrict__ Bt, int M, int N, __half* shm,
                          int tid, Epi epi) {
  using namespace g8;
  constexpr int KK = 1024;
  const int sb0 = tid * 16, sb1 = sb0 + 8192;
  int vo0, vo1;
  {
    int r0, c0, r1, c1;
    stage_rc(sb0, r0, c0);
    stage_rc(sb1, r1, c1);
    vo0 = r0 * KK + c0;
    vo1 = r1 * KK + c1;
  }
#define SA(b, h) (shm + ((b)*2 + (h)) * HT)
#define SB(b, h) (shm + (4 + (b)*2 + (h)) * HT)
#define STAGE(P, BASE, br, kt)                                                                             \
  do {                                                                                                     \
    const __half* _gb = (BASE) + (long)(br)*KK + (long)(kt)*BK;                                            \
    __builtin_amdgcn_global_load_lds((const unsigned*)(_gb + vo0),                                         \
                                     (__attribute__((address_space(3))) unsigned*)((char*)(P) + sb0), 16, 0, 0); \
    __builtin_amdgcn_global_load_lds((const unsigned*)(_gb + vo1),                                         \
                                     (__attribute__((address_space(3))) unsigned*)((char*)(P) + sb1), 16, 0, 0); \
  } while (0)
#define LDA(dst, b, h)                                                                                     \
  for (int m = 0; m < 4; ++m)                                                                              \
    for (int k = 0; k < 2; ++k)                                                                            \
  dst[m][k] = *reinterpret_cast<const f16x8*>((char*)SA(b, h) + lds_byte(wr * 64 + m * 16 + fr, k * 32 + fq * 8))
#define LDB(dst, b, h)                                                                                     \
  for (int n = 0; n < 2; ++n)                                                                              \
    for (int k = 0; k < 2; ++k)                                                                            \
  dst[n][k] = *reinterpret_cast<const f16x8*>((char*)SB(b, h) + lds_byte(wc * 32 + n * 16 + fr, k * 32 + fq * 8))
#define MMA(ai, bj, At_, Bt_)                                                                              \
  do {                                                                                                     \
    __builtin_amdgcn_s_setprio(1);                                                                         \
    for (int m = 0; m < 4; ++m)                                                                            \
      for (int n = 0; n < 2; ++n)                                                                          \
        for (int k = 0; k < 2; ++k)                                                                        \
          acc[ai][bj][m][n] =                                                                              \
              __builtin_amdgcn_mfma_f32_16x16x32_f16(Bt_[n][k], At_[m][k], acc[ai][bj][m][n], 0, 0, 0);  \
    __builtin_amdgcn_s_setprio(0);                                                                         \
  } while (0)
#define WAIT_V(n) asm volatile("s_waitcnt vmcnt(" #n ")" ::: "memory")
#define WAIT_L(n) asm volatile("s_waitcnt lgkmcnt(" #n ")" ::: "memory")
#define BAR __builtin_amdgcn_s_barrier()
#define SCHED __builtin_amdgcn_sched_barrier(0)
  const int nM = M / BM, nN = N / BM, nwg = nM * nN;
  const int wid = tid >> 6, lane = tid & 63, wr = wid >> 2, wc = wid & 3, fr = lane & 15, fq = lane >> 4;
  constexpr int nt = KK / BK;
  for (int tile = blockIdx.x; tile < nwg; tile += gridDim.x) {
    int wgid = tile;
    {
      int q = nwg / NXCD, r = nwg % NXCD, xcd = wgid % NXCD, off = wgid / NXCD;
      wgid = (xcd < r ? xcd * (q + 1) : r * (q + 1) + (xcd - r) * q) + off;
    }
    int nig = WGM * nN, gid = wgid / nig, fm = gid * WGM, gsz = min(nM - fm, WGM);
    int pm = fm + ((wgid % nig) % gsz), pn = (wgid % nig) / gsz, brow = pm * BM, bcol = pn * BM;
    f32x4 acc[2][2][4][2] = {};
    f16x8 At[4][2], B0[2][2], B1[2][2];
    STAGE(SB(0, 0), Bt, bcol, 0);
    STAGE(SA(0, 0), A, brow, 0);
    STAGE(SB(0, 1), Bt, bcol + HALF, 0);
    STAGE(SA(0, 1), A, brow + HALF, 0);
    if (wr == 1) BAR;
    WAIT_V(4);
    BAR;
    STAGE(SB(1, 0), Bt, bcol, 1);
    STAGE(SA(1, 0), A, brow, 1);
    STAGE(SB(1, 1), Bt, bcol + HALF, 1);
    WAIT_V(6);
    BAR;
    for (int t = 0; t < nt - 2; t += 2) {
      LDB(B0, 0, 0); SCHED; LDA(At, 0, 0); STAGE(SA(1, 1), A, brow + HALF, t + 1);
      WAIT_L(8); BAR; WAIT_L(0); MMA(0, 0, At, B0); BAR; SCHED;
      LDB(B1, 0, 1); STAGE(SB(0, 0), Bt, bcol, t + 2);
      BAR; WAIT_L(0); MMA(0, 1, At, B1); BAR;
      LDA(At, 0, 1); STAGE(SA(0, 0), A, brow, t + 2);
      BAR; WAIT_L(0); MMA(1, 0, At, B0); BAR; SCHED;
      STAGE(SB(0, 1), Bt, bcol + HALF, t + 2);
      WAIT_V(6); BAR; MMA(1, 1, At, B1); BAR;
      LDB(B0, 1, 0); SCHED; LDA(At, 1, 0); STAGE(SA(0, 1), A, brow + HALF, t + 2);
      WAIT_L(8); BAR; WAIT_L(0); MMA(0, 0, At, B0); BAR; SCHED;
      LDB(B1, 1, 1); STAGE(SB(1, 0), Bt, bcol, t + 3);
      BAR; WAIT_L(0); MMA(0, 1, At, B1); BAR;
      LDA(At, 1, 1); STAGE(SA(1, 0), A, brow, t + 3);
      BAR; WAIT_L(0); MMA(1, 0, At, B0); BAR; SCHED;
      STAGE(SB(1, 1), Bt, bcol + HALF, t + 3);
      WAIT_V(6); BAR; MMA(1, 1, At, B1); BAR;
    }
    {
      LDB(B0, 0, 0); LDA(At, 0, 0); STAGE(SA(1, 1), A, brow + HALF, nt - 1);
      BAR; WAIT_L(0); MMA(0, 0, At, B0); BAR;
      LDB(B1, 0, 1); BAR; WAIT_L(0); MMA(0, 1, At, B1); BAR;
      LDA(At, 0, 1); WAIT_V(4); BAR; WAIT_L(0); MMA(1, 0, At, B0); MMA(1, 1, At, B1); BAR;
    }
    {
      LDB(B0, 1, 0); LDA(At, 1, 0); WAIT_V(2); BAR; WAIT_L(0); MMA(0, 0, At, B0); BAR;
      LDB(B1, 1, 1); WAIT_V(0); BAR; WAIT_L(0); MMA(0, 1, At, B1); BAR;
      LDA(At, 1, 1); BAR; WAIT_L(0); MMA(1, 0, At, B0); MMA(1, 1, At, B1); BAR;
    }
    if (wr == 0) BAR;
    {
      int t2 = tid;
      asm volatile("" : "+v"(t2));
      const int ewid = t2 >> 6, el = t2 & 63, ewr = ewid >> 2, ewc = ewid & 3, efr = el & 15, efq = el >> 4;
      epi(brow, bcol, acc, ewr * 64 + efr, ewc * 32 + efq * 4);
    }
  }
#undef SA
#undef SB
#undef STAGE
#undef LDA
#undef LDB
#undef MMA
}

__device__ void phaseC(const Params& p, __half* shm, int tid) {
  auto epi = [&](int brow, int bcol, const f32x4(&acc)[2][2][4][2], int r0, int c0) {
    if (bcol >= 1024 && bcol < 1536) {
#pragma unroll
      for (int ai = 0; ai < 2; ++ai)
#pragma unroll
        for (int bj = 0; bj < 2; ++bj)
#pragma unroll
          for (int m = 0; m < 4; ++m)
#pragma unroll
            for (int n = 0; n < 2; ++n) {
              __half* vt = p.VT + (size_t)(bcol - 1024 + bj * 128 + n * 16 + c0) * LT + (brow + ai * 128 + m * 16 + r0);
              const f32x4 v = acc[ai][bj][m][n];
              vt[0] = __float2half(v[0]);
              vt[LT] = __float2half(v[1]);
              vt[2 * LT] = __float2half(v[2]);
              vt[3 * LT] = __float2half(v[3]);
            }
    } else if (bcol >= 4096) {
      if (c0 < 16) {
#pragma unroll
        for (int ai = 0; ai < 2; ++ai)
#pragma unroll
          for (int m = 0; m < 4; ++m)
            *(f32x4*)(p.GBA + (size_t)(brow + ai * 128 + m * 16 + r0) * 16 + c0) = acc[ai][0][m][0];
      }
    } else {
      __half* base;
      int ld;
      if (bcol < 1024) {
        base = p.NAP + bcol; ld = 1536;
      } else if (bcol < 2048) {
        base = p.NAP + (bcol - 512); ld = 1536;
      } else if (bcol < 3584) {
        base = p.GQ + (bcol - 2048); ld = 1536;
      } else {
        base = p.GZ + (bcol - 3584); ld = 512;
      }
#pragma unroll
      for (int ai = 0; ai < 2; ++ai)
#pragma unroll
        for (int m = 0; m < 4; ++m) {
          __half* rowp = base + (size_t)(brow + ai * 128 + m * 16 + r0) * ld + c0;
#pragma unroll
          for (int bj = 0; bj < 2; ++bj)
#pragma unroll
            for (int n = 0; n < 2; ++n) store_h4(rowp + bj * 128 + n * 16, acc[ai][bj][m][n]);
        }
    }
  };
  gemm_mfma(p.H, p.WtI, LT, NPAD, shm, tid, epi);
}

__device__ void phaseD_gdnpre(const Params& p, int tid) {
  const int lane = tid & 63;
  const int gw = blockIdx.x * NWV + (tid >> 6);
  const int nw3 = (gridDim.x * NWV) / 3;
  const int third = gw % 3, slot = gw / 3;
  if (slot >= nw3) return;
  const int c16 = lane & 15;
  const int axis = c16 >> 3, hq = c16 & 3;
  const bool first = (c16 & 4) == 0;
  const int ch = third * 512 + lane * 8;
  float wv[5][8];
#pragma unroll
  for (int j = 0; j < 5; ++j) {
    const f32x4 w0 = *(const f32x4*)(p.conv_w + j * 1536 + ch), w1 = *(const f32x4*)(p.conv_w + j * 1536 + ch + 4);
#pragma unroll
    for (int e = 0; e < 4; ++e) {
      wv[j][e] = w0[e];
      wv[j][4 + e] = w1[e];
    }
  }
  const float dtb = (lane < 8) ? p.dt_bias[lane] : 0.f, aexp = (lane < 8) ? -expf(p.A_log[lane]) : 0.f;
  for (int r0 = slot; r0 < LT; r0 += 2 * nw3) {
    f16x8 xv[2][5];
    float msk[2][5];
    f32x4 cs4[2][4];
    float gb[2], ga[2];
#pragma unroll
    for (int u = 0; u < 2; ++u) {
      const int r = min(r0 + u * nw3, LT - 1);
      const int pos = (r < L) ? r : r - L, len = (r < L) ? L : CTX, base = (r < L) ? 0 : L;
#pragma unroll
      for (int j = 0; j < 5; ++j) {
        const int pp = pos + j - 2;
        const bool ok = (pp >= 0 && pp < len);
        msk[u][j] = ok ? 1.f : 0.f;
        const f16x8 xl = *(const f16x8*)(p.GQ + (size_t)(base + min(max(pp, 0), len - 1)) * 1536 + ch);
        xv[u][j] = ok ? xl : (f16x8){};
      }
      const int tr = (axis == 0) ? (pos / GW) : (256 + pos % GW);
      const f32x4* csp = (const f32x4*)(p.ROPE + (size_t)(tr * 32 + hq * 8) * 2);
#pragma unroll
      for (int e = 0; e < 4; ++e) cs4[u][e] = csp[e];
      gb[u] = (lane < 8) ? p.GBA[(size_t)r * 16 + lane] : 0.f;
      ga[u] = (lane < 8) ? p.GBA[(size_t)r * 16 + 8 + lane] : 0.f;
    }
#pragma unroll
    for (int u = 0; u < 2; ++u) {
      const int r = r0 + u * nw3;
      if (r >= LT) break;
      float a[8];
#pragma unroll
      for (int e = 0; e < 8; ++e) a[e] = 0.f;
#pragma unroll
      for (int j = 0; j < 5; ++j)
#pragma unroll
        for (int e = 0; e < 8; ++e) a[e] += wv[j][e] * (float)xv[u][j][e];
#pragma unroll
      for (int e = 0; e < 8; ++e) a[e] = siluf(a[e]);
      if (third < 2) {
        float ss = 0.f;
#pragma unroll
        for (int e = 0; e < 8; ++e) ss += a[e] * a[e];
        ss += __shfl_xor(ss, 1, 64);
        ss += __shfl_xor(ss, 2, 64);
        ss += __shfl_xor(ss, 4, 64);
        ss += __shfl_xor(ss, 8, 64);
        const float inv = rsqrtf(ss + EPS);
#pragma unroll
        for (int e = 0; e < 8; ++e) a[e] *= inv;
        if (r < L) {
#pragma unroll
          for (int e = 0; e < 8; ++e) {
            const float other = __shfl_xor(a[e], 4, 64);
            const float cc = cs4[u][e >> 1][(e & 1) * 2], sn = cs4[u][e >> 1][(e & 1) * 2 + 1];
            a[e] = first ? (a[e] * cc - other * sn) : (a[e] * cc + other * sn);
          }
        }
      }
      {
        __half2 h[4];
#pragma unroll
        for (int e = 0; e < 4; ++e) h[e] = __floats2half2_rn(a[2 * e], a[2 * e + 1]);
        *(uint4*)(p.QKV + (size_t)r * 1536 + ch) = *(uint4*)h;
      }
      if (third == 0 && lane < 8) {
        const float beta = __builtin_amdgcn_rcpf(1.f + __expf(-gb[u]));
        const float xx = ga[u] + dtb;
        const float sp = (xx > 20.f) ? xx : log1pf(expf(xx));
        p.BETA[(size_t)r * 8 + lane] = beta;
        p.GG[(size_t)r * 8 + lane] = aexp * sp;
      }
    }
  }
}

#define MFMA16(a, b, c) __builtin_amdgcn_mfma_f32_16x16x32_f16(a, b, c, 0, 0, 0)
__device__ void phaseNA(const Params& p, float* smem, int tid, int b0, int nb) {
  const int lane = tid & 63, w = tid >> 6, fr = lane & 15, fq = lane >> 4;
  const int t = w & 3, g = w >> 2;
  float* rp = smem;
  float* xch = smem + 512;
  int hcur = -1;
  for (int item = (int)blockIdx.x - b0; item < 2048; item += nb) {
    const int r = item >> 3, h = item & 7;
    if (h != hcur) {
      __syncthreads();
      for (int i = tid; i < 465; i += NT) rp[i] = p.rpb[h * 465 + i];
      hcur = h;
      __syncthreads();
    }
    const int rs = min(max(r - 4, 0), 248);
    const int ws = (t == 0) ? 0 : (t == 1) ? 8 : (t == 2) ? 24 : 32;
    const int c = 16 * t + fr;
    const int cs = min(max(c - 8, 0), 48);
    const int tq = r * 64 + c;
    f16x8 qf[2];
    qf[0] = *(const f16x8*)(p.NAP + (size_t)tq * 1536 + h * 64 + 8 * fq);
    qf[1] = *(const f16x8*)(p.NAP + (size_t)tq * 1536 + h * 64 + 32 + 8 * fq);
    f32x4 s[16];
    {
      f16x8 kb[32];
#pragma unroll
      for (int nt = 0; nt < 16; ++nt) {
        const int tb = (g == 0) ? (rs + (nt >> 1)) * 64 + ws : L + 32 * (nt >> 1);
        const int tokr = tb + 8 * (fr >> 2) + 4 * (nt & 1) + (fr & 3);
        const __half* kp = p.NAP + (size_t)tokr * 1536 + 512 + h * 64 + 8 * fq;
        kb[2 * nt] = *(const f16x8*)kp;
        kb[2 * nt + 1] = *(const f16x8*)(kp + 32);
      }
#pragma unroll
      for (int nt = 0; nt < 16; ++nt) {
        f32x4 acc = {0.f, 0.f, 0.f, 0.f};
        acc = MFMA16(kb[2 * nt], qf[0], acc);
        acc = MFMA16(kb[2 * nt + 1], qf[1], acc);
        s[nt] = acc;
      }
    }
    f16x8 vb[32];
#pragma unroll
    for (int ks = 0; ks < 8; ++ks) {
      const int tokA = ((g == 0) ? (rs + ks) * 64 + ws : L + 32 * ks) + 8 * fq;
#pragma unroll
      for (int nd = 0; nd < 4; ++nd) vb[4 * ks + nd] = *(const f16x8*)(p.VT + (size_t)(h * 64 + 16 * nd + fr) * LT + tokA);
    }
    float m = -1e30f;
#pragma unroll
    for (int nt = 0; nt < 16; ++nt)
#pragma unroll
      for (int rr = 0; rr < 4; ++rr) {
        float v = s[nt][rr] * 0.125f;
        if (g == 0) {
          const int i = nt >> 1, kc = ws + 8 * fq + 4 * (nt & 1) + rr;
          const bool ok = (kc >= cs) && (kc < cs + 16);
          const float bias = rp[(rs + i - r + 7) * 31 + min(max(kc - c + 15, 0), 30)];
          v = ok ? v + bias : -1e30f;
        }
        s[nt][rr] = v;
        m = fmaxf(m, v);
      }
    m = fmaxf(m, __shfl_xor(m, 16, 64));
    m = fmaxf(m, __shfl_xor(m, 32, 64));
    float l = 0.f;
#pragma unroll
    for (int nt = 0; nt < 16; ++nt)
#pragma unroll
      for (int rr = 0; rr < 4; ++rr) {
        const float e = __expf(s[nt][rr] - m);
        s[nt][rr] = e;
        l += e;
      }
    l += __shfl_xor(l, 16, 64);
    l += __shfl_xor(l, 32, 64);
    f32x4 o[4];
#pragma unroll
    for (int nd = 0; nd < 4; ++nd) o[nd] = (f32x4){0.f, 0.f, 0.f, 0.f};
#pragma unroll
    for (int ks = 0; ks < 8; ++ks) {
      f16x8 pf;
#pragma unroll
      for (int j = 0; j < 4; ++j) {
        pf[j] = (_Float16)s[2 * ks][j];
        pf[4 + j] = (_Float16)s[2 * ks + 1][j];
      }
#pragma unroll
      for (int nd = 0; nd < 4; ++nd) {
        o[nd] = MFMA16(vb[4 * ks + nd], pf, o[nd]);
      }
    }
    float* xc = xch + (t * 64 + lane) * 18;
    if (g == 1) {
      xc[0] = m;
      xc[1] = l;
#pragma unroll
      for (int nd = 0; nd < 4; ++nd)
#pragma unroll
        for (int rr = 0; rr < 4; ++rr) xc[2 + nd * 4 + rr] = o[nd][rr];
    }
    __syncthreads();
    if (g == 0) {
      const float m1 = xc[0], l1 = xc[1];
      const float mm = fmaxf(m, m1);
      const float a0 = __expf(m - mm), a1 = __expf(m1 - mm);
      const float inv = 1.f / (l * a0 + l1 * a1);
#pragma unroll
      for (int nd = 0; nd < 4; ++nd) {
        const f16x4 z = *(const f16x4*)(p.NAP + (size_t)tq * 1536 + 1024 + h * 64 + 16 * nd + 4 * fq);
        f32x4 ov;
#pragma unroll
        for (int rr = 0; rr < 4; ++rr) ov[rr] = (o[nd][rr] * a0 + xc[2 + nd * 4 + rr] * a1) * inv * siluf((float)z[rr]);
        store_h4(p.MIX + (size_t)tq * 1024 + h * 64 + 16 * nd + 4 * fq, ov);
      }
    }
    __syncthreads();
  }
}

__device__ inline int seqrow(int dir, int n) {
  if (dir == 0) return (n < CTX) ? (L + n) : (n - CTX);
  return (n < CTX) ? (L + CTX - 1 - n) : (L - 1 - (n - CTX));
}
constexpr int NCH = LT / 64;
constexpr int E1_SPLIT = 71;

__device__ void phaseE1(const Params& p, float* smem, int tid, int b0, int nb, int idx_lo, int idx_hi) {
  const int lane = tid & 63, w = tid >> 6, fr = lane & 15, fq = lane >> 4;
  float* Am = smem + w * (64 * 68);
  float* gs = smem + 8 * (64 * 68) + w * 128;
  const float scale = 0.08838834764831845f;
  for (int idx = idx_lo + ((int)blockIdx.x - b0) + w * nb; idx < idx_hi; idx += nb * NWV) {
    const int chain = idx & 7, n = idx >> 3;
    const int item = chain * NCH + n;
    const int dir = chain >> 2, hd = chain & 3;
    const int row_s = seqrow(dir, n * 64 + lane);
    const float g = p.GG[(size_t)row_s * 8 + dir * 4 + hd], beta = p.BETA[(size_t)row_s * 8 + dir * 4 + hd];
    float gc = g;
#pragma unroll
    for (int o = 1; o < 64; o <<= 1) {
      float t = __shfl_up(gc, o, 64);
      if (lane >= o) gc += t;
    }
    const float gl = __shfl(gc, 63, 64);
    {
      const float e = __expf(gc);
      float* sc = p.SC + (size_t)item * 320;
      sc[lane] = beta * e;
      sc[64 + lane] = __expf(gl - gc);
      sc[128 + lane] = scale * e;
      sc[192 + lane] = beta;
      if (lane == 0) sc[256] = __expf(gl);
    }
    gs[lane] = gc;
    gs[64 + lane] = beta;
    f16x8 kf[4][4];
    auto loadk = [&]() {
#pragma unroll
      for (int m = 0; m < 4; ++m) {
        const int row = seqrow(dir, n * 64 + 16 * m + fr);
        const __half* base = p.QKV + (size_t)row * 1536 + 512 + hd * 128 + 8 * fq;
#pragma unroll
        for (int kk = 0; kk < 4; ++kk) kf[m][kk] = *(const f16x8*)(base + 32 * kk);
      }
    };
    loadk();
    __builtin_amdgcn_wave_barrier();
#pragma unroll
    for (int mi = 0; mi < 4; ++mi) {
      const f32x4 gci = *(const f32x4*)(gs + 16 * mi + 4 * fq);
      const f32x4 bti = *(const f32x4*)(gs + 64 + 16 * mi + 4 * fq);
#pragma unroll
      for (int nj = 0; nj <= mi; ++nj) {
        f32x4 acc = {0.f, 0.f, 0.f, 0.f};
#pragma unroll
        for (int kk = 0; kk < 4; ++kk) acc = MFMA16(kf[mi][kk], kf[nj][kk], acc);
        const int j = 16 * nj + fr;
        const float gcj = gs[j];
#pragma unroll
        for (int r = 0; r < 4; ++r) {
          const int i = 16 * mi + 4 * fq + r;
          float val = bti[r] * acc[r] * __expf(fminf(gci[r] - gcj, 0.f));
          Am[i * 68 + j] = (i > j) ? val : 0.f;
        }
      }
    }
    __builtin_amdgcn_wave_barrier();
    {
      int lane_i = lane;
      asm volatile("" : "+v"(lane_i));
      float Ar[64], Tr[64];
#pragma unroll
      for (int j4 = 0; j4 < 16; ++j4) {
        const f32x4 av = *(const f32x4*)(Am + lane_i * 68 + 4 * j4);
#pragma unroll
        for (int e = 0; e < 4; ++e) Ar[4 * j4 + e] = (4 * j4 + e < lane_i) ? av[e] : 0.f;
      }
#pragma unroll
      for (int c = 0; c < 64; ++c) Tr[c] = (c == lane_i) ? 1.f : 0.f;
#pragma unroll
      for (int j = 0; j < 63; ++j) {
#pragma unroll
        for (int c = 0; c <= j; ++c) {
          const float tjc = __builtin_bit_cast(float, __builtin_amdgcn_readlane(__builtin_bit_cast(int, Tr[c]), j));
          Tr[c] -= Ar[j] * tjc;
        }
      }
      __half* Tb = p.TB + (size_t)item * 4096 + lane_i * 64;
#pragma unroll
      for (int c8 = 0; c8 < 8; ++c8) {
        __half2 h[4];
#pragma unroll
        for (int e = 0; e < 4; ++e) h[e] = __floats2half2_rn(Tr[8 * c8 + 2 * e], Tr[8 * c8 + 2 * e + 1]);
        *(uint4*)(Tb + 8 * c8) = *(uint4*)h;
      }
    }
    asm volatile("" ::: "memory");
    loadk();
    __half* Qb = p.QKM + (size_t)item * 4096;
#pragma unroll
    for (int mi = 0; mi < 4; ++mi) {
      f16x8 qf[4];
      {
        const int row = seqrow(dir, n * 64 + 16 * mi + fr);
        const __half* base = p.QKV + (size_t)row * 1536 + hd * 128 + 8 * fq;
#pragma unroll
        for (int kk = 0; kk < 4; ++kk) qf[kk] = *(const f16x8*)(base + 32 * kk);
      }
      const int i = 16 * mi + fr;
      const float gci = gs[i];
#pragma unroll
      for (int nj = 0; nj < 4; ++nj) {
        f32x4 acc = {0.f, 0.f, 0.f, 0.f};
        if (nj <= mi) {
#pragma unroll
          for (int kk = 0; kk < 4; ++kk) acc = MFMA16(kf[nj][kk], qf[kk], acc);
          const f32x4 gcj = *(const f32x4*)(gs + 16 * nj + 4 * fq);
#pragma unroll
          for (int r = 0; r < 4; ++r) {
            const int j = 16 * nj + 4 * fq + r;
            float val = acc[r] * scale * __expf(fminf(gci - gcj[r], 0.f));
            acc[r] = (i >= j) ? val : 0.f;
          }
        }
        store_h4(Qb + i * 64 + 16 * nj + 4 * fq, acc);
      }
    }
    __builtin_amdgcn_wave_barrier();
  }
}

__device__ void phaseE2(const Params& p, float* smem, int tid) {
  const int chain = blockIdx.x & 7, slice = blockIdx.x >> 3, dir = chain >> 2, hd = chain & 3, e0 = slice * 16;
  const int lane = tid & 63, w = __builtin_amdgcn_readfirstlane(tid >> 6), fr = lane & 15, fq = lane >> 4;
  char* lds = (char*)smem;
  constexpr int SLOT = 56576, O_K = 0, O_Q = 17408, O_T = 34816, O_QK = 44032, O_V = 53248, O_SC = 55296;
  constexpr int O_ST = 2 * SLOT;
  constexpr int O_VN = O_ST + 3 * 4352;
  constexpr int O_RHS = O_VN + 2 * 2304;
  constexpr int O_VND = O_RHS + 2304;
  constexpr int O_DMY = O_VND + 2304;
  static_assert(O_DMY + 512 * 16 <= LDS_BYTES, "scan LDS map");
  __half* Od = dir ? p.OB : p.OF;
  auto relrow = [&](int pos) { return dir ? 63 - pos : pos; };
  auto rowbase = [&](int m) { return dir == 0 ? (m < 4 ? L + 64 * m : 64 * (m - 4)) : (m < 4 ? L + 192 - 64 * m : L - 64 * (m - 3)); };

  for (int i = tid; i < 16 * 136; i += NT) ((__half*)(lds + O_ST))[i] = __float2half(0.f);

  if (w >= 2) {
    unsigned goff0 = 0, loff0 = 0, goff1 = 0, loff1 = 0, goff2 = 0, loff2 = 0, goff3 = 0, loff3 = 0, goff4 = 0, loff4 = 0, goff5 = 0, loff5 = 0, goff6 = 0, loff6 = 0, goff7 = 0, loff7 = 0, goff8 = 0, loff8 = 0, goff9 = 0, loff9 = 0, goff10 = 0, loff10 = 0, goff11 = 0, loff11 = 0;
    auto piece = [&](int j, unsigned& g, unsigned& l) {
      g = 0;
      l = O_DMY + tid * 16;
      if (w <= 5 && j < 8) {
        const int f = ((tid - 128) & 127) + 128 * j, pos = f >> 4, c16 = f & 15;
        g = relrow(pos) * 3072u + ((w <= 3 ? 512 : 0) + hd * 128 + c16 * 8) * 2u;
        l = (w <= 3 ? O_K : O_Q) + pos * 272 + c16 * 16;
      } else if (w >= 6 && j < 8) {
        const int f = lane + 64 * j;
        if (!((f >> 3) < 32 && (f & 7) >= 4)) {
          g = f * 16u;
          l = (w == 6 ? O_T : O_QK) + (f >> 3) * 144 + (f & 7) * 16;
        }
      } else if (w == 7 && j < 10) {
        const int f = lane + 64 * (j - 8);
        g = relrow(f >> 1) * 3072u + (1024 + hd * 128 + e0 + (f & 1) * 8) * 2u;
        l = O_V + (f >> 1) * 32 + (f & 1) * 16;
      } else if (w == 7) {
        const int f = lane + 64 * (j - 10);
        if (f < 80) {
          g = f * 16u;
          l = O_SC + f * 16;
        }
      }
    };
    piece(0, goff0, loff0);
    piece(1, goff1, loff1);
    piece(2, goff2, loff2);
    piece(3, goff3, loff3);
    piece(4, goff4, loff4);
    piece(5, goff5, loff5);
    piece(6, goff6, loff6);
    piece(7, goff7, loff7);
    piece(8, goff8, loff8);
    piece(9, goff9, loff9);
    piece(10, goff10, loff10);
    piece(11, goff11, loff11);
    uint4 R0_0 = {}, R0_1 = {}, R0_2 = {}, R0_3 = {}, R0_4 = {}, R0_5 = {}, R0_6 = {}, R0_7 = {}, R0_8 = {}, R0_9 = {}, R0_10 = {}, R0_11 = {}, R1_0 = {}, R1_1 = {}, R1_2 = {}, R1_3 = {}, R1_4 = {}, R1_5 = {}, R1_6 = {}, R1_7 = {}, R1_8 = {}, R1_9 = {}, R1_10 = {}, R1_11 = {}, R2_0 = {}, R2_1 = {}, R2_2 = {}, R2_3 = {}, R2_4 = {}, R2_5 = {}, R2_6 = {}, R2_7 = {}, R2_8 = {}, R2_9 = {}, R2_10 = {}, R2_11 = {};
#define LD_ISSUE(S, mm)                                                                                   \
  do {                                                                                                    \
    const int m_ = min((mm), NCH - 1);                                                                    \
    const size_t item_ = (size_t)chain * NCH + m_;                                                        \
    const char* b0_ = (const char*)(p.QKV + (size_t)rowbase(m_) * 1536);                                  \
    const char* bA_ = (w <= 5) ? b0_ : (w == 6 ? (const char*)(p.TB + item_ * 4096) : (const char*)(p.QKM + item_ * 4096)); \
    const char* bS_ = (w == 7) ? (const char*)(p.SC + item_ * 320) : b0_;                                 \
    R##S##_0 = *(const uint4*)(bA_ + goff0);                                                         \
    R##S##_1 = *(const uint4*)(bA_ + goff1);                                                         \
    R##S##_2 = *(const uint4*)(bA_ + goff2);                                                         \
    R##S##_3 = *(const uint4*)(bA_ + goff3);                                                         \
    R##S##_4 = *(const uint4*)(bA_ + goff4);                                                         \
    R##S##_5 = *(const uint4*)(bA_ + goff5);                                                         \
    R##S##_6 = *(const uint4*)(bA_ + goff6);                                                         \
    R##S##_7 = *(const uint4*)(bA_ + goff7);                                                         \
    R##S##_8 = *(const uint4*)(b0_ + goff8);                                                         \
    R##S##_9 = *(const uint4*)(b0_ + goff9);                                                         \
    R##S##_10 = *(const uint4*)(bS_ + goff10);                                                         \
    R##S##_11 = *(const uint4*)(bS_ + goff11);                                                         \
  } while (0)
#define LD_WRITE(S, mm)                                                                                   \
  do {                                                                                                    \
    char* sl_ = lds + ((mm)&1) * SLOT;                                                                    \
    *(uint4*)((loff0 >= (unsigned)O_DMY ? lds : sl_) + loff0) = R##S##_0;                           \
    *(uint4*)((loff1 >= (unsigned)O_DMY ? lds : sl_) + loff1) = R##S##_1;                           \
    *(uint4*)((loff2 >= (unsigned)O_DMY ? lds : sl_) + loff2) = R##S##_2;                           \
    *(uint4*)((loff3 >= (unsigned)O_DMY ? lds : sl_) + loff3) = R##S##_3;                           \
    *(uint4*)((loff4 >= (unsigned)O_DMY ? lds : sl_) + loff4) = R##S##_4;                           \
    *(uint4*)((loff5 >= (unsigned)O_DMY ? lds : sl_) + loff5) = R##S##_5;                           \
    *(uint4*)((loff6 >= (unsigned)O_DMY ? lds : sl_) + loff6) = R##S##_6;                           \
    *(uint4*)((loff7 >= (unsigned)O_DMY ? lds : sl_) + loff7) = R##S##_7;                           \
    if (w == 7) {                      \
      *(uint4*)((loff8 >= (unsigned)O_DMY ? lds : sl_) + loff8) = R##S##_8;                         \
      *(uint4*)((loff9 >= (unsigned)O_DMY ? lds : sl_) + loff9) = R##S##_9;                         \
      *(uint4*)((loff10 >= (unsigned)O_DMY ? lds : sl_) + loff10) = R##S##_10;                         \
      *(uint4*)((loff11 >= (unsigned)O_DMY ? lds : sl_) + loff11) = R##S##_11;                         \
    }                                                                                                     \
  } while (0)
    LD_ISSUE(0, 0);
    LD_ISSUE(1, 1);
    LD_ISSUE(2, 2);
    LD_WRITE(0, 0);
    __syncthreads();
    static_assert(NCH % 3 == 2, "loader tail assumes NCH = 3k + 2");
    for (int n = 0; n < NCH - 2; n += 3) {
      if (n == E1_SPLIT - 8) {
        if (lane == 0) {
          const unsigned want = gridDim.x - 64;
          unsigned spins = 0;
          while (__hip_atomic_load(p.E1DONE, __ATOMIC_RELAXED, __HIP_MEMORY_SCOPE_AGENT) < want && ++spins < (1u << 24)) __builtin_amdgcn_s_sleep(2);
        }
        __builtin_amdgcn_fence(__ATOMIC_ACQUIRE, "agent");
        asm volatile("s_waitcnt vmcnt(0)" ::: "memory");
      }
      LD_ISSUE(0, n + 3); LD_WRITE(1, n + 1); __syncthreads();
      LD_ISSUE(1, n + 4); LD_WRITE(2, n + 2); __syncthreads();
      LD_ISSUE(2, n + 5); LD_WRITE(0, n + 3); __syncthreads();
    }
    LD_WRITE(1, NCH - 1); __syncthreads();
    __syncthreads();
#undef LD_ISSUE
#undef LD_WRITE
  } else if (w == 0) {
    f32x4 Sacc[8];
#pragma unroll
    for (int d = 0; d < 8; ++d) Sacc[d] = (f32x4){0.f, 0.f, 0.f, 0.f};
    __half* rhsT = (__half*)(lds + O_RHS);
    __half* vndT = (__half*)(lds + O_VND);
    __syncthreads();
    int n3 = 0;
    for (int n = 0; n < NCH; ++n) {
      const char* sl = lds + (n & 1) * SLOT;
      const __half* kc = (const __half*)(sl + O_K);
      const __half* tc = (const __half*)(sl + O_T);
      const float* sc = (const float*)(sl + O_SC);
      const __half* STc = (const __half*)(lds + O_ST + n3 * 4352);
      const int n3n = (n3 == 2) ? 0 : n3 + 1;
      __half* STn = (__half*)(lds + O_ST + n3n * 4352);
      __half* vnT = (__half*)(lds + O_VN + (n & 1) * 2304);
      f16x8 Sf[4], kfr[4][4], tf[6];
      f32x4 be[4], bt[4], dd[4];
      unsigned short uv[4][4];
#pragma unroll
      for (int kk = 0; kk < 4; ++kk) Sf[kk] = *(const f16x8*)(STc + fr * 136 + 32 * kk + 8 * fq);
#pragma unroll
      for (int m = 0; m < 4; ++m) {
#pragma unroll
        for (int kk = 0; kk < 4; ++kk) kfr[m][kk] = *(const f16x8*)(kc + (16 * m + fr) * 136 + 32 * kk + 8 * fq);
        be[m] = *(const f32x4*)(sc + 16 * m + 4 * fq);
        bt[m] = *(const f32x4*)(sc + 192 + 16 * m + 4 * fq);
        dd[m] = *(const f32x4*)(sc + 64 + 16 * m + 4 * fq);
        const unsigned short* vp = (const unsigned short*)(sl + O_V) + (16 * m + 4 * fq) * 16 + fr;
        uv[m][0] = vp[0]; uv[m][1] = vp[16]; uv[m][2] = vp[32]; uv[m][3] = vp[48];
      }
      tf[0] = *(const f16x8*)(tc + (0 + fr) * 72 + 8 * fq);
      tf[1] = *(const f16x8*)(tc + (16 + fr) * 72 + 8 * fq);
      tf[2] = *(const f16x8*)(tc + (32 + fr) * 72 + 8 * fq);
      tf[3] = *(const f16x8*)(tc + (32 + fr) * 72 + 32 + 8 * fq);
      tf[4] = *(const f16x8*)(tc + (48 + fr) * 72 + 8 * fq);
      tf[5] = *(const f16x8*)(tc + (48 + fr) * 72 + 32 + 8 * fq);
      const float glast = sc[256];
      __builtin_amdgcn_sched_barrier(0);
      f32x4 ks[4];
#pragma unroll
      for (int m = 0; m < 4; ++m) ks[m] = (f32x4){0.f, 0.f, 0.f, 0.f};
#pragma unroll
      for (int kk = 0; kk < 4; ++kk)
#pragma unroll
        for (int m = 0; m < 4; ++m) ks[m] = MFMA16(kfr[m][kk], Sf[kk], ks[m]);
#pragma unroll
      for (int m = 0; m < 4; ++m) {
        f32x4 rhs;
#pragma unroll
        for (int r = 0; r < 4; ++r) rhs[r] = bt[m][r] * __half2float(__ushort_as_half(uv[m][r])) - be[m][r] * ks[m][r];
        store_h4(rhsT + fr * 72 + 16 * m + 4 * fq, rhs);
      }
      f16x8 rf[2];
      rf[0] = *(const f16x8*)(rhsT + fr * 72 + 8 * fq);
      rf[1] = *(const f16x8*)(rhsT + fr * 72 + 32 + 8 * fq);
      f16x8 ktf[8][2];
#pragma unroll
      for (int d = 0; d < 8; ++d)
#pragma unroll
        for (int kk = 0; kk < 2; ++kk) {
          const __half* kb = kc + (32 * kk + 8 * fq + (fr >> 2)) * 136 + 16 * d + 4 * (fr & 3);
          const h16x4 lo = __builtin_amdgcn_ds_read_tr16_b64_v4f16((__attribute__((address_space(3))) h16x4*)(kb));
          const h16x4 hi = __builtin_amdgcn_ds_read_tr16_b64_v4f16((__attribute__((address_space(3))) h16x4*)(kb + 4 * 136));
          const f16x4 lo4 = __builtin_bit_cast(f16x4, lo), hi4 = __builtin_bit_cast(f16x4, hi);
          ktf[d][kk] = (f16x8){lo4[0], lo4[1], lo4[2], lo4[3], hi4[0], hi4[1], hi4[2], hi4[3]};
        }
      __builtin_amdgcn_sched_barrier(0);
      f32x4 vnv[4];
      vnv[0] = MFMA16(tf[0], rf[0], ((f32x4){0.f, 0.f, 0.f, 0.f}));
      vnv[1] = MFMA16(tf[1], rf[0], ((f32x4){0.f, 0.f, 0.f, 0.f}));
      vnv[2] = MFMA16(tf[2], rf[0], ((f32x4){0.f, 0.f, 0.f, 0.f}));
      vnv[3] = MFMA16(tf[4], rf[0], ((f32x4){0.f, 0.f, 0.f, 0.f}));
      vnv[2] = MFMA16(tf[3], rf[1], vnv[2]);
      vnv[3] = MFMA16(tf[5], rf[1], vnv[3]);
#pragma unroll
      for (int m = 0; m < 4; ++m) {
        store_h4(vnT + fr * 72 + 16 * m + 4 * fq, vnv[m]);
        f32x4 vd;
#pragma unroll
        for (int r = 0; r < 4; ++r) vd[r] = vnv[m][r] * dd[m][r];
        store_h4(vndT + fr * 72 + 16 * m + 4 * fq, vd);
      }
      f16x8 vdf[2];
      vdf[0] = *(const f16x8*)(vndT + fr * 72 + 8 * fq);
      vdf[1] = *(const f16x8*)(vndT + fr * 72 + 32 + 8 * fq);
#pragma unroll
      for (int d = 0; d < 8; ++d)
#pragma unroll
        for (int r = 0; r < 4; ++r) Sacc[d][r] *= glast;
      __builtin_amdgcn_sched_barrier(0);
#pragma unroll
      for (int kk = 0; kk < 2; ++kk)
#pragma unroll
        for (int d = 0; d < 8; ++d) Sacc[d] = MFMA16(ktf[d][kk], vdf[kk], Sacc[d]);
#pragma unroll
      for (int d = 0; d < 8; ++d) store_h4(STn + fr * 136 + 16 * d + 4 * fq, Sacc[d]);
      n3 = n3n;
      __syncthreads();
    }
  } else {
    f32x4 accq[4], sep[4];
    f16x8 qkp[4][2];
#pragma unroll
    for (int m = 0; m < 4; ++m) {
      accq[m] = (f32x4){0.f, 0.f, 0.f, 0.f};
      sep[m] = (f32x4){0.f, 0.f, 0.f, 0.f};
      qkp[m][0] = (f16x8){};
      qkp[m][1] = (f16x8){};
    }
    const unsigned ocol4 = (hd * 128 + e0 + 4 * fq) * 2u;
    auto emit = [&](int np) {
      const __half* vnT = (const __half*)(lds + O_VN + (np & 1) * 2304);
      f16x8 vf[2];
      vf[0] = *(const f16x8*)(vnT + fr * 72 + 8 * fq);
      vf[1] = *(const f16x8*)(vnT + fr * 72 + 32 + 8 * fq);
      char* ob = (char*)(Od + (size_t)rowbase(np) * 512);
      __builtin_amdgcn_sched_barrier(0);
      f32x4 o[4];
#pragma unroll
      for (int m = 0; m < 4; ++m)
#pragma unroll
        for (int r = 0; r < 4; ++r) o[m][r] = sep[m][0] * accq[m][r];
#pragma unroll
      for (int m = 0; m < 4; ++m) o[m] = MFMA16(vf[0], qkp[m][0], o[m]);
      o[2] = MFMA16(vf[1], qkp[2][1], o[2]);
      o[3] = MFMA16(vf[1], qkp[3][1], o[3]);
      if (np >= 4) {
#pragma unroll
        for (int m = 0; m < 4; ++m) store_h4((__half*)(ob + relrow(16 * m + fr) * 1024u + ocol4), o[m]);
      }
    };
    __syncthreads();
    int n3 = 0;
    for (int n = 0; n < NCH; ++n) {
      const char* sl = lds + (n & 1) * SLOT;
      const __half* qc = (const __half*)(sl + O_Q);
      const __half* mc = (const __half*)(sl + O_QK);
      const float* sc = (const float*)(sl + O_SC);
      const __half* STc = (const __half*)(lds + O_ST + n3 * 4352);
      if (n > 0) emit(n - 1);
      f16x8 Sf[4], qfr[4][4];
#pragma unroll
      for (int kk = 0; kk < 4; ++kk) Sf[kk] = *(const f16x8*)(STc + fr * 136 + 32 * kk + 8 * fq);
#pragma unroll
      for (int m = 0; m < 4; ++m) {
#pragma unroll
        for (int kk = 0; kk < 4; ++kk) qfr[m][kk] = *(const f16x8*)(qc + (16 * m + fr) * 136 + 32 * kk + 8 * fq);
        sep[m][0] = sc[128 + 16 * m + fr];
        qkp[m][0] = *(const f16x8*)(mc + (16 * m + fr) * 72 + 8 * fq);
        qkp[m][1] = *(const f16x8*)(mc + (16 * m + fr) * 72 + 32 + 8 * fq);
      }
      __builtin_amdgcn_sched_barrier(0);
#pragma unroll
      for (int m = 0; m < 4; ++m) accq[m] = (f32x4){0.f, 0.f, 0.f, 0.f};
#pragma unroll
      for (int kk = 0; kk < 4; ++kk)
#pragma unroll
        for (int m = 0; m < 4; ++m) accq[m] = MFMA16(Sf[kk], qfr[m][kk], accq[m]);
      n3 = (n3 == 2) ? 0 : n3 + 1;
      __syncthreads();
    }
    emit(NCH - 1);
  }
}

__device__ void phaseF(const Params& p, int tid) {
  const int lane = tid & 63;
  const int gw = blockIdx.x * NWV + (tid >> 6);
  const int nw = gridDim.x * NWV;
  const f32x4 nw0 = *(const f32x4*)(p.gdn_norm_w + (lane & 15) * 8), nw1 = *(const f32x4*)(p.gdn_norm_w + (lane & 15) * 8 + 4);
  for (int t0 = gw; t0 < L; t0 += 2 * nw) {
    f16x8 vf[2], vb[2], z[2];
#pragma unroll
    for (int u = 0; u < 2; ++u) {
      const size_t o = (size_t)min(t0 + u * nw, L - 1) * 512 + lane * 8;
      vf[u] = *(const f16x8*)(p.OF + o);
      vb[u] = *(const f16x8*)(p.OB + o);
      z[u] = *(const f16x8*)(p.GZ + o);
    }
#pragma unroll
    for (int u = 0; u < 2; ++u) {
      const int t = t0 + u * nw;
      if (t >= L) break;
      float v[8];
      float ss = 0.f;
#pragma unroll
      for (int e = 0; e < 8; ++e) {
        v[e] = (float)vf[u][e] + (float)vb[u][e];
        ss += v[e] * v[e];
      }
      ss += __shfl_xor(ss, 1, 64);
      ss += __shfl_xor(ss, 2, 64);
      ss += __shfl_xor(ss, 4, 64);
      ss += __shfl_xor(ss, 8, 64);
      const float inv = rsqrtf(ss * (1.f / 128.f) + EPS);
      __half2 h[4];
#pragma unroll
      for (int e = 0; e < 4; ++e) {
        const float w0 = (2 * e < 4) ? nw0[2 * e] : nw1[2 * e - 4], w1 = (2 * e + 1 < 4) ? nw0[2 * e + 1] : nw1[2 * e + 1 - 4];
        h[e] = __floats2half2_rn(v[2 * e] * inv * w0 * siluf((float)z[u][2 * e]), v[2 * e + 1] * inv * w1 * siluf((float)z[u][2 * e + 1]));
      }
      *(uint4*)(p.MIX + (size_t)t * 1024 + 512 + lane * 8) = *(uint4*)h;
    }
  }
}

__device__ void phaseG(const Params& p, __half* shm, int tid) {
  auto epi = [&](int brow, int bcol, const f32x4(&acc)[2][2][4][2], int r0, int c0) {
#pragma unroll
    for (int ai = 0; ai < 2; ++ai)
#pragma unroll
      for (int m = 0; m < 4; ++m) {
        __half* rowp = p.Y + (size_t)(brow + ai * 128 + m * 16 + r0) * 1024 + bcol + c0;
#pragma unroll
        for (int bj = 0; bj < 2; ++bj)
#pragma unroll
          for (int n = 0; n < 2; ++n) store_h4(rowp + bj * 128 + n * 16, acc[ai][bj][m][n]);
      }
  };
  gemm_mfma(p.MIX, p.WtO, L, 1024, shm, tid, epi);
}

__device__ void phaseH(const Params& p, int tid) {
  int lane = tid & 63;
  int gw = blockIdx.x * NWV + (tid >> 6);
  int nw = gridDim.x * NWV;
  float4 gg[2][2];
#pragma unroll
  for (int i = 0; i < 2; ++i)
#pragma unroll
    for (int hh = 0; hh < 2; ++hh) {
      const int j = i * 512 + lane * 8 + 4 * hh;
      const float4 g = *(const float4*)(p.g_post + j), gt = *(const float4*)(p.mod + 2048 + j);
      gg[i][hh] = make_float4(g.x * gt.x, g.y * gt.y, g.z * gt.z, g.w * gt.w);
    }
  for (int r0 = gw; r0 < L; r0 += 2 * nw) {
    f16x8 y[2][2];
    float4 xv[2][2][2];
#pragma unroll
    for (int u = 0; u < 2; ++u) {
      const int r = min(r0 + u * nw, L - 1);
#pragma unroll
      for (int i = 0; i < 2; ++i) {
        const int j = i * 512 + lane * 8;
        y[u][i] = *(const f16x8*)(p.Y + (size_t)r * D + j);
        xv[u][i][0] = *(const float4*)(p.x + (size_t)r * D + j);
        xv[u][i][1] = *(const float4*)(p.x + (size_t)r * D + j + 4);
      }
    }
#pragma unroll
    for (int u = 0; u < 2; ++u) {
      const int r = r0 + u * nw;
      if (r >= L) break;
      float ss = 0.f;
#pragma unroll
      for (int i = 0; i < 2; ++i)
#pragma unroll
        for (int e = 0; e < 8; ++e) ss += (float)y[u][i][e] * (float)y[u][i][e];
      ss = wsum(ss);
      const float inv = rsqrtf(ss * (1.f / D) + EPS);
#pragma unroll
      for (int i = 0; i < 2; ++i) {
        const int j = i * 512 + lane * 8;
#pragma unroll
        for (int hh = 0; hh < 2; ++hh) {
          const float4 x4 = xv[u][i][hh], f = gg[i][hh];
          float4 o;
          o.x = x4.x + f.x * ((float)y[u][i][4 * hh + 0] * inv);
          o.y = x4.y + f.y * ((float)y[u][i][4 * hh + 1] * inv);
          o.z = x4.z + f.z * ((float)y[u][i][4 * hh + 2] * inv);
          o.w = x4.w + f.w * ((float)y[u][i][4 * hh + 3] * inv);
          *(float4*)(p.out + (size_t)r * D + j + 4 * hh) = o;
        }
      }
    }
  }
}

__device__ __forceinline__ int fresh_tid(int wave_s) {
  int lane;
  asm volatile("v_mbcnt_lo_u32_b32 %0, -1, 0\n\tv_mbcnt_hi_u32_b32 %0, -1, %0" : "=v"(lane));
  return wave_s * 64 + lane;
}

constexpr size_t al256(size_t b) { return (b + 255) & ~(size_t)255; }
constexpr size_t OFF_MOD = 0;
constexpr size_t OFF_WTI = OFF_MOD + al256(2 * 3072 * 4);
constexpr size_t OFF_WTO = OFF_WTI + al256((size_t)NPAD * 1024 * 2);
constexpr size_t OFF_H = OFF_WTO + al256((size_t)1024 * 1024 * 2);
constexpr size_t OFF_NAP = OFF_H + al256((size_t)LT * 1024 * 2);
constexpr size_t OFF_VT = OFF_NAP + al256((size_t)LT * 1536 * 2);
constexpr size_t OFF_GQ = OFF_VT + al256((size_t)512 * LT * 2);
constexpr size_t OFF_GZ = OFF_GQ + al256((size_t)LT * 1536 * 2);
constexpr size_t OFF_GBA = OFF_GZ + al256((size_t)LT * 512 * 2);
constexpr size_t OFF_QKV = OFF_GBA + al256((size_t)LT * 16 * 4);
constexpr size_t OFF_BETA = OFF_QKV + al256((size_t)LT * 1536 * 2);
constexpr size_t OFF_GG = OFF_BETA + al256((size_t)LT * 8 * 4);
constexpr size_t OFF_QKM = OFF_GG + al256((size_t)LT * 8 * 4);
constexpr size_t OFF_SC = OFF_QKM + al256((size_t)8 * 260 * 4096 * 2);
constexpr size_t OFF_ROPE = OFF_SC + al256((size_t)8 * 260 * 320 * 4);
constexpr size_t OFF_BAR = OFF_ROPE + al256((size_t)320 * 32 * 2 * 4) + 256;
constexpr size_t WS_TOTAL = OFF_BAR + al256((size_t)3456 * 4);
static_assert(WS_TOTAL <= (size_t)256 * 1024 * 1024, "workspace map exceeds 256 MiB");

struct KArgs {
  const float* in[15];
  float* out;
  char* ws;
};

__device__ __forceinline__ Params make_params(const KArgs& a) {
  unsigned long long wsi = (unsigned long long)a.ws;
  asm volatile("" : "+s"(wsi));
  char* ws = (char*)(__attribute__((address_space(1))) char*)wsi;
  Params p;
  p.x = a.in[0]; p.c = a.in[1]; p.ctx = a.in[2]; p.c_ctx = a.in[3]; p.w_ada = a.in[4]; p.b_ada = a.in[5];
  p.g_pre = a.in[6]; p.g_post = a.in[7]; p.w_in = a.in[8]; p.conv_w = a.in[9]; p.rpb = a.in[10];
  p.A_log = a.in[11]; p.dt_bias = a.in[12]; p.gdn_norm_w = a.in[13]; p.w_out = a.in[14];
  p.out = a.out;
  p.mod = (float*)(ws + OFF_MOD);
  p.WtI = (__half*)(ws + OFF_WTI);
  p.WtO = (__half*)(ws + OFF_WTO);
  p.H = (__half*)(ws + OFF_H);
  p.MIX = p.H;
  p.NAP = (__half*)(ws + OFF_NAP);
  p.VT = (__half*)(ws + OFF_VT);
  p.Y = (__half*)(ws + OFF_NAP);
  p.GQ = (__half*)(ws + OFF_GQ);
  p.OF = p.GQ;
  p.OB = p.GQ + (size_t)L * 512;
  p.TB = p.GQ + (size_t)2 * L * 512;
  p.GZ = (__half*)(ws + OFF_GZ);
  p.GBA = (float*)(ws + OFF_GBA);
  p.QKV = (__half*)(ws + OFF_QKV);
  p.BETA = (float*)(ws + OFF_BETA);
  p.GG = (float*)(ws + OFF_GG);
  p.QKM = (__half*)(ws + OFF_QKM);
  p.SC = (float*)(ws + OFF_SC);
  p.ROPE = (float*)(ws + OFF_ROPE);
  p.E1DONE = (unsigned*)(ws + OFF_BAR) + 64;
  return p;
}

#define XB_TMO 128
#define XB_XCNT(j) (256 + 64 * (j))
#define XB_XSUB(j) (1280 + 64 * (j))
#define XB_XGEN(j) (2304 + 64 * (j))
#define XB_TOP 3328
#define XB_TOPGEN 3392
#define XCD_BAR_WORDS 3456
#define XB_SPIN_CAP (1u << 18)
#define XB_LAS __attribute__((address_space(3)))
__device__ __forceinline__ unsigned xb_ld(unsigned* p) { return __hip_atomic_load(p, __ATOMIC_RELAXED, __HIP_MEMORY_SCOPE_AGENT); }
__device__ __forceinline__ unsigned xb_add(unsigned* p, unsigned v) { return __hip_atomic_fetch_add(p, v, __ATOMIC_RELAXED, __HIP_MEMORY_SCOPE_AGENT); }
__device__ __forceinline__ unsigned xb_xcc_id() { return (unsigned)__builtin_amdgcn_s_getreg((3 << 11) | 20) & 0xFu; }
#define XB_SPIN(cond, bar)                                                   \
  do {                                                                       \
    unsigned _sp = 0;                                                        \
    while (cond) {                                                           \
      __builtin_amdgcn_s_sleep(1);                                           \
      if ((++_sp & 255u) == 0u) {                                            \
        if (xb_ld(&(bar)[XB_TMO])) break;                                    \
        if (_sp > XB_SPIN_CAP) {                                             \
          atomicAdd(&(bar)[XB_TMO], 1u);                                     \
          break;                                                             \
        }                                                                    \
      }                                                                      \
    }                                                                        \
  } while (0)
struct XcdBarrier {
  unsigned* bar;
  unsigned x;
  volatile XB_LAS unsigned* st;
};
__device__ __forceinline__ XcdBarrier xcd_barrier_post(unsigned* bar, volatile XB_LAS unsigned* st) {
  XcdBarrier b;
  b.bar = bar;
  b.x = xb_xcc_id();
  b.st = st;
  if (threadIdx.x == 0) (void)xb_add(&bar[XB_XCNT(b.x)], 1u);
  return b;
}
__device__ __forceinline__ void xcd_barrier_complete(unsigned* bar, unsigned x, unsigned& nloc, unsigned& nx) {
  const unsigned G = gridDim.x * gridDim.y * gridDim.z;
  unsigned sum, cnt, mine, sp = 0u;
  for (;;) {
    sum = 0u; cnt = 0u; mine = 0u;
#pragma unroll
    for (unsigned j = 0; j < 16; ++j) {
      const unsigned c = xb_ld(&bar[XB_XCNT(j)]);
      sum += c;
      cnt += (c > 0u) ? 1u : 0u;
      mine = (j == x) ? c : mine;
    }
    if (sum == G) break;
    __builtin_amdgcn_s_sleep(1);
    if ((++sp & 255u) == 0u) {
      if (xb_ld(&bar[XB_TMO])) break;
      if (sp > XB_SPIN_CAP) {
        atomicAdd(&bar[XB_TMO], 1u);
        break;
      }
    }
  }
  nloc = mine > 0u ? mine : 1u;
  nx = cnt > 0u ? cnt : 1u;
}
__device__ __forceinline__ void xcd_barrier(const XcdBarrier& b) {
  asm volatile("s_waitcnt vmcnt(0)" ::: "memory");
  __syncthreads();
  if (threadIdx.x == 0) {
    unsigned* bar = b.bar;
    __builtin_amdgcn_s_waitcnt(0);
    unsigned nloc = b.st[0], nx = b.st[1];
    if (nloc == 0u) {
      xcd_barrier_complete(bar, b.x, nloc, nx);
      b.st[0] = nloc;
      b.st[1] = nx;
    }
    const unsigned old = xb_add(&bar[XB_XSUB(b.x)], 1u);
    const unsigned gen = old / nloc;
    if (old + 1u == (gen + 1u) * nloc) {
      __builtin_amdgcn_fence(__ATOMIC_RELEASE, "agent");
      asm volatile("s_waitcnt vmcnt(0)" ::: "memory");
      const unsigned og = xb_add(&bar[XB_TOP], 1u);
      const unsigned tg = og / nx;
      if (og + 1u == (tg + 1u) * nx) xb_add(&bar[XB_TOPGEN], 1u);
      else XB_SPIN(xb_ld(&bar[XB_TOPGEN]) == tg, bar);
      __builtin_amdgcn_fence(__ATOMIC_ACQUIRE, "agent");
      xb_add(&bar[XB_XGEN(b.x)], 1u);
      asm volatile("s_waitcnt vmcnt(0)" ::: "memory");
    } else {
      XB_SPIN(xb_ld(&bar[XB_XGEN(b.x)]) == gen, bar);
      __builtin_amdgcn_fence(__ATOMIC_ACQUIRE, "agent");
      asm volatile("s_waitcnt vmcnt(0)" ::: "memory");
    }
  }
  __syncthreads();
}

__device__ __forceinline__ void grid_barrier(unsigned* ctr, unsigned target) {
  asm volatile("s_waitcnt vmcnt(0)" ::: "memory");
  __syncthreads();
  if (threadIdx.x == 0) {
    __builtin_amdgcn_fence(__ATOMIC_RELEASE, "agent");
    asm volatile("s_waitcnt vmcnt(0)" ::: "memory");
    __hip_atomic_fetch_add(ctr, 1u, __ATOMIC_RELAXED, __HIP_MEMORY_SCOPE_AGENT);
    unsigned spins = 0;
    while (__hip_atomic_load(ctr, __ATOMIC_RELAXED, __HIP_MEMORY_SCOPE_AGENT) < target && ++spins < (1u << 24))
      __builtin_amdgcn_s_sleep(1);
    __builtin_amdgcn_fence(__ATOMIC_ACQUIRE, "agent");
    asm volatile("s_waitcnt vmcnt(0)" ::: "memory");
  }
  __syncthreads();
}

template <int PH>
__device__ void run_phase(const KArgs& a, float* smem, int wave_s) {
  const int tid = fresh_tid(wave_s);
  const Params p = make_params(a);
  if constexpr (PH == 0) phaseA(p, smem, tid);
  if constexpr (PH == 1) phaseB(p, tid);
  if constexpr (PH == 2) phaseC(p, (__half*)smem, tid);
  if constexpr (PH == 3) phaseD_gdnpre(p, tid);
  if constexpr (PH == 4) phaseE1(p, smem, tid, 0, gridDim.x, 0, 8 * E1_SPLIT);
  if constexpr (PH == 8) {
    if (blockIdx.x < 64) {
      phaseE2(p, smem, tid);
    } else {
      phaseE1(p, smem, tid, 64, gridDim.x - 64, 8 * E1_SPLIT, 8 * NCH);
      asm volatile("s_waitcnt vmcnt(0)" ::: "memory");
      __syncthreads();
      if (tid == 0) {
        __builtin_amdgcn_fence(__ATOMIC_RELEASE, "agent");
        asm volatile("s_waitcnt vmcnt(0)" ::: "memory");
        __hip_atomic_fetch_add(p.E1DONE, 1u, __ATOMIC_RELAXED, __HIP_MEMORY_SCOPE_AGENT);
      }
      phaseNA(p, smem, tid, 64, gridDim.x - 64);
    }
  }
  if constexpr (PH == 5) phaseF(p, tid);
  if constexpr (PH == 6) phaseG(p, (__half*)smem, tid);
  if constexpr (PH == 7) phaseH(p, tid);
}

__global__ void __launch_bounds__(NT, 2) mega(KArgs a) {
  extern __shared__ __attribute__((aligned(16))) float smem[];
  cg::grid_group grid = cg::this_grid();
  const int wave_s = __builtin_amdgcn_readfirstlane((int)(hipThreadIdx_x >> 6));
#ifdef TPROBE
#define TSTAMP(k) ts##k = wall_clock64()
  unsigned long long ts0 = 0, ts1 = 0, ts2 = 0, ts3 = 0, ts4 = 0, ts5 = 0, ts6 = 0, ts7 = 0, ts8 = 0;
#else
#define TSTAMP(k)
#endif
  unsigned* const bar = (unsigned*)(a.ws + OFF_BAR);
  volatile XB_LAS unsigned* const xst = (volatile XB_LAS unsigned*)((XB_LAS char*)smem + (LDS_BYTES - 16));
  if (blockIdx.x == 0)
    for (int i = threadIdx.x; i < XCD_BAR_WORDS; i += NT) __hip_atomic_store(bar + i, 0u, __ATOMIC_RELAXED, __HIP_MEMORY_SCOPE_AGENT);
  if (threadIdx.x == 0) {
    xst[0] = 0u;
    xst[1] = 0u;
  }
  TSTAMP(0);
  run_phase<0>(a, smem, wave_s); grid.sync(); TSTAMP(1);
  const XcdBarrier xb = xcd_barrier_post(bar, xst);
  run_phase<1>(a, smem, wave_s); xcd_barrier(xb); TSTAMP(2);
  run_phase<2>(a, smem, wave_s); xcd_barrier(xb); TSTAMP(3);
  run_phase<3>(a, smem, wave_s); xcd_barrier(xb); TSTAMP(4);
  run_phase<4>(a, smem, wave_s); xcd_barrier(xb); TSTAMP(5);
  run_phase<8>(a, smem, wave_s); xcd_barrier(xb); TSTAMP(6);
  run_phase<5>(a, smem, wave_s); xcd_barrier(xb); TSTAMP(7);
  run_phase<6>(a, smem, wave_s); xcd_barrier(xb); TSTAMP(8);
  run_phase<7>(a, smem, wave_s);
#ifdef TPROBE
  __syncthreads();
  if (blockIdx.x == 0) {
    int cnt = (int)((TPROBE_HI - TPROBE_LO) / 100);
    cnt = cnt > 1000 ? 1000 : cnt;
    for (int i = threadIdx.x; i < cnt; i += NT) a.out[i] += 0.1f;
  }
#endif
}

extern "C" void kernel_launch(void* const* d_in, const int* in_sizes, int n_in, void* d_out, int out_size, void* d_ws,
                              size_t ws_size, hipStream_t stream) {
  KArgs a{};
  for (int i = 0; i < 15; ++i) a.in[i] = (const float*)d_in[i];
  a.out = (float*)d_out;
  a.ws = (char*)d_ws;
  static int grid_blocks = 0;
  if (!grid_blocks) {
    int dev = 0, cus = 0, per_cu = 0;
    (void)hipGetDevice(&dev);
    (void)hipDeviceGetAttribute(&cus, hipDeviceAttributeMultiprocessorCount, dev);
    (void)hipFuncSetAttribute((const void*)mega, hipFuncAttributeMaxDynamicSharedMemorySize, LDS_BYTES);
    (void)hipOccupancyMaxActiveBlocksPerMultiprocessor(&per_cu, mega, NT, LDS_BYTES);
    if (per_cu < 1) per_cu = 1;
    grid_blocks = cus * per_cu;
  }
  void* args[] = {&a};
  hipError_t e = hipLaunchCooperativeKernel((void*)mega, dim3(grid_blocks), dim3(NT), args, LDS_BYTES, stream);
  if (e != hipSuccess) fprintf(stderr, "cooperative launch failed: %s (grid %d)\n", hipGetErrorString(e), grid_blocks);
}

#ifdef DIAG_PHASES
template <int PH>
__global__ void __launch_bounds__(NT, 2) phase_k(KArgs a) {
  extern __shared__ __attribute__((aligned(16))) float smem[];
  run_phase<PH>(a, smem, (int)(hipThreadIdx_x >> 6));
}
template __global__ void phase_k<2>(KArgs);
template __global__ void phase_k<3>(KArgs);
template __global__ void phase_k<4>(KArgs);
template __global__ void phase_k<8>(KArgs);
template __global__ void phase_k<6>(KArgs);
#endif
```

```cpp
#include <hip/hip_runtime.h>
#include <hip/hip_fp16.h>
#include <hip/hip_cooperative_groups.h>
#include <cstdio>
namespace cg = cooperative_groups;

#ifndef MK_MULTI
#define MK_MULTI 0
#endif

constexpr int L = 16384, CTX = 256, LT = L + CTX, D = 1024, IN_DIM = 4112;
constexpr int NT = 512, NWV = NT / 64;
constexpr int NPAD = 4352;
constexpr int LDS_BYTES = 147456;
typedef _Float16 f16x8 __attribute__((ext_vector_type(8)));
typedef _Float16 f16x4 __attribute__((ext_vector_type(4)));
typedef __fp16 h16x4 __attribute__((__vector_size__(4 * sizeof(__fp16))));
typedef float f32x4 __attribute__((ext_vector_type(4)));
constexpr int GW = 64;
constexpr float EPS = 1e-6f;

struct Params {
  const float *x, *c, *ctx, *c_ctx, *w_ada, *b_ada, *g_pre, *g_post, *w_in, *conv_w, *rpb, *A_log, *dt_bias,
      *gdn_norm_w, *w_out;
  float* out;
  float* mod;
  __half* WtI;
  __half* WtO;
  __half* H;
  __half* NAP;
  __half* VT;
  __half* GQ;
  __half* GZ;
  float* GBA;
  __half* QKV;
  float* BETA;
  float* GG;
  __half* TB;
  __half* QKM;
  float* SC;
  unsigned* E1DONE;
  float* ROPE;
  __half* OF;
  __half* OB;
  __half* MIX;
  __half* Y;
};

__device__ inline float wsum(float v) {
#pragma unroll
  for (int o = 32; o > 0; o >>= 1) v += __shfl_xor(v, o, 64);
  return v;
}
__device__ inline float wmax(float v) {
#pragma unroll
  for (int o = 32; o > 0; o >>= 1) v = fmaxf(v, __shfl_xor(v, o, 64));
  return v;
}
__device__ inline void store_h4(__half* dst, f32x4 v) {
  __half2 h[2] = {__floats2half2_rn(v[0], v[1]), __floats2half2_rn(v[2], v[3])};
  *(uint2*)dst = *(uint2*)h;
}

__device__ inline float siluf(float x) { return x * __builtin_amdgcn_rcpf(1.f + __expf(-x)); }

__device__ void transpose_tiles(const float* W, int ld, int Nvalid, int Npad, __half* Wt, float* smem, int tid, int b0,
                                int nb) {
  const int tn = Npad / 64, ntile = 16 * tn;
  const int kk0 = tid >> 4, n4 = (tid & 15) * 4;
  auto fetch = [&](int tile, float4& v0, float4& v1) {
    const int tk = tile / tn, tc = tile % tn;
    const int col = tc * 64 + n4;
    const float* src = W + (size_t)(tk * 64 + kk0) * ld + col;
    const bool ok = (tile < ntile) && (col < Nvalid);
    v0 = ok ? *(const float4*)src : make_float4(0.f, 0.f, 0.f, 0.f);
    v1 = ok ? *(const float4*)(src + (size_t)32 * ld) : make_float4(0.f, 0.f, 0.f, 0.f);
  };
  float4 c0, c1, x0, x1;
  int tile = (int)blockIdx.x - b0;
  fetch(tile, c0, c1);
  for (; tile < ntile; tile += nb) {
    fetch(tile + nb, x0, x1);
    const int tk = tile / tn, tc = tile % tn;
    __syncthreads();
    smem[kk0 * 65 + n4 + 0] = c0.x; smem[kk0 * 65 + n4 + 1] = c0.y; smem[kk0 * 65 + n4 + 2] = c0.z; smem[kk0 * 65 + n4 + 3] = c0.w;
    smem[(kk0 + 32) * 65 + n4 + 0] = c1.x; smem[(kk0 + 32) * 65 + n4 + 1] = c1.y;
    smem[(kk0 + 32) * 65 + n4 + 2] = c1.z; smem[(kk0 + 32) * 65 + n4 + 3] = c1.w;
    __syncthreads();
    {
      int nn = tid >> 3, k8 = (tid & 7) * 8;
      __half2 h[4];
#pragma unroll
      for (int i = 0; i < 4; ++i)
        h[i] = __floats2half2_rn(smem[(k8 + 2 * i) * 65 + nn], smem[(k8 + 2 * i + 1) * 65 + nn]);
      *(uint4*)(Wt + (size_t)(tc * 64 + nn) * 1024 + tk * 64 + k8) = *(uint4*)h;
    }
    c0 = x0;
    c1 = x1;
  }
}

__device__ void phaseA(const Params& p, float* smem, int tid) {
  int lane = tid & 63, w = tid >> 6;
  for (int item = blockIdx.x; item < 48; item += gridDim.x) {
    int j = item * 64 + lane;
    float a0 = 0.f, a1 = 0.f;
    int k0 = w * 128;
#pragma unroll 8
    for (int k = k0; k < k0 + 128; ++k) {
      float wv = p.w_ada[(size_t)k * 3072 + j];
      a0 += siluf(p.c[k]) * wv;
      a1 += siluf(p.c_ctx[k]) * wv;
    }
    __syncthreads();
    smem[(w * 2 + 0) * 64 + lane] = a0;
    smem[(w * 2 + 1) * 64 + lane] = a1;
    __syncthreads();
    if (w < 2) {
      float s = 0.f;
#pragma unroll
      for (int ww = 0; ww < NWV; ++ww) s += smem[(ww * 2 + w) * 64 + lane];
      p.mod[w * 3072 + j] = s + p.b_ada[j];
    }
  }
  for (int i = blockIdx.x * NT + tid; i < 320 * 32; i += gridDim.x * NT) {
    const int tr = i >> 5, fi = i & 31;
    const float posv = (float)((tr < 256) ? tr : tr - 256);
    const float ang = posv * powf(10000.f, -(float)(2 * fi) / 64.f);
    p.ROPE[2 * i] = cosf(ang);
    p.ROPE[2 * i + 1] = sinf(ang);
  }
  const int b0 = (gridDim.x > 96) ? 48 : 0, nb = gridDim.x - b0;
  if ((int)blockIdx.x >= b0) {
    transpose_tiles(p.w_in, IN_DIM, IN_DIM, NPAD, p.WtI, smem, tid, b0, nb);
    transpose_tiles(p.w_out, 1024, 1024, 1024, p.WtO, smem, tid, b0, nb);
  }
}

__device__ void phaseB(const Params& p, int tid) {
  int lane = tid & 63;
  int gw = blockIdx.x * NWV + (tid >> 6);
  int nw = gridDim.x * NWV;
  float4 fa[4], fb[4];
  auto factors = [&](const float* md) {
#pragma unroll
    for (int i = 0; i < 4; ++i) {
      const int j = i * 256 + lane * 4;
      const float4 g = *(const float4*)(p.g_pre + j), sh = *(const float4*)(md + j), sc = *(const float4*)(md + 1024 + j);
      fa[i] = make_float4(g.x * (1.f + sc.x), g.y * (1.f + sc.y), g.z * (1.f + sc.z), g.w * (1.f + sc.w));
      fb[i] = sh;
    }
  };
  factors(p.mod);
  bool ctx_f = false;
  for (int r0 = gw; r0 < LT; r0 += 2 * nw) {
    float4 v[2][4];
#pragma unroll
    for (int u = 0; u < 2; ++u) {
      const int r = min(r0 + u * nw, LT - 1);
      const float* src = (r < L) ? p.x + (size_t)r * D : p.ctx + (size_t)(r - L) * D;
#pragma unroll
      for (int i = 0; i < 4; ++i) v[u][i] = *(const float4*)(src + i * 256 + lane * 4);
    }
#pragma unroll
    for (int u = 0; u < 2; ++u) {
      const int r = r0 + u * nw;
      if (r >= LT) break;
      if (r >= L && !ctx_f) {
        factors(p.mod + 3072);
        ctx_f = true;
      }
      float ss = 0.f;
#pragma unroll
      for (int i = 0; i < 4; ++i) ss += v[u][i].x * v[u][i].x + v[u][i].y * v[u][i].y + v[u][i].z * v[u][i].z + v[u][i].w * v[u][i].w;
      ss = wsum(ss);
      const float inv = rsqrtf(ss * (1.f / D) + EPS);
#pragma unroll
      for (int i = 0; i < 4; ++i) {
        const int j = i * 256 + lane * 4;
        const float o0 = v[u][i].x * inv * fa[i].x + fb[i].x;
        const float o1 = v[u][i].y * inv * fa[i].y + fb[i].y;
        const float o2 = v[u][i].z * inv * fa[i].z + fb[i].z;
        const float o3 = v[u][i].w * inv * fa[i].w + fb[i].w;
        __half2 h[2] = {__floats2half2_rn(o0, o1), __floats2half2_rn(o2, o3)};
        *(uint2*)(p.H + (size_t)r * D + j) = *(uint2*)h;
      }
    }
  }
}

namespace g8 {
constexpr int BM = 256, BK = 64, HALF = 128, NXCD = 8, WGM = 8, HT = HALF * BK;
__device__ __forceinline__ int lds_byte(int r, int c) {
  int st = (r >> 4) * 2 + (c >> 5), rr = r & 15, cc = c & 31, ob = rr * 64 + cc * 2;
  return st * 1024 + (ob ^ (((ob >> 9) & 1) << 5));
}
__device__ __forceinline__ void stage_rc(int b, int& R, int& C) {
  int st = b / 1024, sb = b % 1024, swz = sb ^ (((sb >> 9) & 1) << 5);
  R = (st >> 1) * 16 + swz / 64;
  C = (st & 1) * 32 + (swz % 64) / 2;
}
}

template <int nM, int nN, int pn0, int ntiles, int pmx, int pnx, class Epi>
__device__ void gemm_mfma(const __half* __restrict__ A, const __half* __restrict__ Bt, __half* shm, int tid, int b0, int nb,
                          Epi epi) {
  using namespace g8;
  constexpr int KK = 1024;
  const int sb0 = tid * 16, sb1 = sb0 + 8192;
  int vo0, vo1;
  {
    int r0, c0, r1, c1;
    stage_rc(sb0, r0, c0);
    stage_rc(sb1, r1, c1);
    vo0 = r0 * KK + c0;
    vo1 = r1 * KK + c1;
  }
#define SA(b, h) (shm + ((b)*2 + (h)) * HT)
#define SB(b, h) (shm + (4 + (b)*2 + (h)) * HT)
#define STAGE(P, BASE, br, kt)                                                                             \
  do {                                                                                                     \
    const __half* _gb = (BASE) + (long)(br)*KK + (long)(kt)*BK;                                            \
    __builtin_amdgcn_global_load_lds((const unsigned*)(_gb + vo0),                                         \
                                     (__attribute__((address_space(3))) unsigned*)((char*)(P) + sb0), 16, 0, 0); \
    __builtin_amdgcn_global_load_lds((const unsigned*)(_gb + vo1),                                         \
                                     (__attribute__((address_space(3))) unsigned*)((char*)(P) + sb1), 16, 0, 0); \
  } while (0)
#define LDA(dst, b, h)                                                                                     \
  for (int m = 0; m < 4; ++m)                                                                              \
    for (int k = 0; k < 2; ++k)                                                                            \
  dst[m][k] = *reinterpret_cast<const f16x8*>((char*)SA(b, h) + lds_byte(wr * 64 + m * 16 + fr, k * 32 + fq * 8))
#define LDB(dst, b, h)                                                                                     \
  for (int n = 0; n < 2; ++n)                                                                              \
    for (int k = 0; k < 2; ++k)                                                                            \
  dst[n][k] = *reinterpret_cast<const f16x8*>((char*)SB(b, h) + lds_byte(wc * 32 + n * 16 + fr, k * 32 + fq * 8))
#define MMA(ai, bj, At_, Bt_)                                                                              \
  do {                                                                                                     \
    __builtin_amdgcn_s_setprio(1);                                                                         \
    for (int m = 0; m < 4; ++m)                                                                            \
      for (int n = 0; n < 2; ++n)                                                                          \
        for (int k = 0; k < 2; ++k)                                                                        \
          acc[ai][bj][m][n] =                                                                              \
              __builtin_amdgcn_mfma_f32_16x16x32_f16(Bt_[n][k], At_[m][k], acc[ai][bj][m][n], 0, 0, 0);  \
    __builtin_amdgcn_s_setprio(0);                                                                         \
  } while (0)
#define WAIT_V(n) asm volatile("s_waitcnt vmcnt(" #n ")" ::: "memory")
#define WAIT_L(n) asm volatile("s_waitcnt lgkmcnt(" #n ")" ::: "memory")
#define BAR __builtin_amdgcn_s_barrier()
#define SCHED __builtin_amdgcn_sched_barrier(0)
  constexpr int nwg = nM * nN;
  const int wid = tid >> 6, lane = tid & 63, wr = wid >> 2, wc = wid & 3, fr = lane & 15, fq = lane >> 4;
  constexpr int nt = KK / BK;
  for (int tile = (int)blockIdx.x - b0; tile < ntiles; tile += nb) {
    int pm, pn;
    if (tile < nwg) {
      int wgid = tile;
      {
        int q = nwg / NXCD, r = nwg % NXCD, xcd = wgid % NXCD, off = wgid / NXCD;
        wgid = (xcd < r ? xcd * (q + 1) : r * (q + 1) + (xcd - r) * q) + off;
      }
      int nig = WGM * nN, gid = wgid / nig, fm = gid * WGM, gsz = min(nM - fm, WGM);
      pm = fm + ((wgid % nig) % gsz);
      pn = pn0 + (wgid % nig) / gsz;
    } else {
      pm = pmx + (tile - nwg);
      pn = pnx;
    }
    const int brow = pm * BM, bcol = pn * BM;
    f32x4 acc[2][2][4][2] = {};
    f16x8 At[4][2], B0[2][2], B1[2][2];
    STAGE(SB(0, 0), Bt, bcol, 0);
    STAGE(SA(0, 0), A, brow, 0);
    STAGE(SB(0, 1), Bt, bcol + HALF, 0);
    STAGE(SA(0, 1), A, brow + HALF, 0);
    if (wr == 1) BAR;
    WAIT_V(4);
    BAR;
    STAGE(SB(1, 0), Bt, bcol, 1);
    STAGE(SA(1, 0), A, brow, 1);
    STAGE(SB(1, 1), Bt, bcol + HALF, 1);
    WAIT_V(6);
    BAR;
    for (int t = 0; t < nt - 2; t += 2) {
      LDB(B0, 0, 0); SCHED; LDA(At, 0, 0); STAGE(SA(1, 1), A, brow + HALF, t + 1);
      WAIT_L(8); BAR; WAIT_L(0); MMA(0, 0, At, B0); BAR; SCHED;
      LDB(B1, 0, 1); STAGE(SB(0, 0), Bt, bcol, t + 2);
      BAR; WAIT_L(0); MMA(0, 1, At, B1); BAR;
      LDA(At, 0, 1); STAGE(SA(0, 0), A, brow, t + 2);
      BAR; WAIT_L(0); MMA(1, 0, At, B0); BAR; SCHED;
      STAGE(SB(0, 1), Bt, bcol + HALF, t + 2);
      WAIT_V(6); BAR; MMA(1, 1, At, B1); BAR;
      LDB(B0, 1, 0); SCHED; LDA(At, 1, 0); STAGE(SA(0, 1), A, brow + HALF, t + 2);
      WAIT_L(8); BAR; WAIT_L(0); MMA(0, 0, At, B0); BAR; SCHED;
      LDB(B1, 1, 1); STAGE(SB(1, 0), Bt, bcol, t + 3);
      BAR; WAIT_L(0); MMA(0, 1, At, B1); BAR;
      LDA(At, 1, 1); STAGE(SA(1, 0), A, brow, t + 3);
      BAR; WAIT_L(0); MMA(1, 0, At, B0); BAR; SCHED;
      STAGE(SB(1, 1), Bt, bcol + HALF, t + 3);
      WAIT_V(6); BAR; MMA(1, 1, At, B1); BAR;
    }
    {
      LDB(B0, 0, 0); LDA(At, 0, 0); STAGE(SA(1, 1), A, brow + HALF, nt - 1);
      BAR; WAIT_L(0); MMA(0, 0, At, B0); BAR;
      LDB(B1, 0, 1); BAR; WAIT_L(0); MMA(0, 1, At, B1); BAR;
      LDA(At, 0, 1); WAIT_V(4); BAR; WAIT_L(0); MMA(1, 0, At, B0); MMA(1, 1, At, B1); BAR;
    }
    {
      LDB(B0, 1, 0); LDA(At, 1, 0); WAIT_V(2); BAR; WAIT_L(0); MMA(0, 0, At, B0); BAR;
      LDB(B1, 1, 1); WAIT_V(0); BAR; WAIT_L(0); MMA(0, 1, At, B1); BAR;
      LDA(At, 1, 1); BAR; WAIT_L(0); MMA(1, 0, At, B0); MMA(1, 1, At, B1); BAR;
    }
    if (wr == 0) BAR;
    {
      int t2 = tid;
      asm volatile("" : "+v"(t2));
      const int ewid = t2 >> 6, el = t2 & 63, ewr = ewid >> 2, ewc = ewid & 3, efr = el & 15, efq = el >> 4;
      epi(brow, bcol, acc, ewr * 64 + efr, ewc * 32 + efq * 4);
    }
  }
#undef SA
#undef SB
#undef STAGE
#undef LDA
#undef LDB
#undef MMA
}

__device__ void phaseC(const Params& p, __half* shm, int tid, bool first, int b0, int nb) {
  auto epi = [&](int brow, int bcol, const f32x4(&acc)[2][2][4][2], int r0, int c0) {
    if (bcol >= 1024 && bcol < 1536) {
#pragma unroll
      for (int ai = 0; ai < 2; ++ai)
#pragma unroll
        for (int bj = 0; bj < 2; ++bj)
#pragma unroll
          for (int m = 0; m < 4; ++m)
#pragma unroll
            for (int n = 0; n < 2; ++n) {
              __half* vt = p.VT + (size_t)(bcol - 1024 + bj * 128 + n * 16 + c0) * LT + (brow + ai * 128 + m * 16 + r0);
              const f32x4 v = acc[ai][bj][m][n];
              vt[0] = __float2half(v[0]);
              vt[LT] = __float2half(v[1]);
              vt[2 * LT] = __float2half(v[2]);
              vt[3 * LT] = __float2half(v[3]);
            }
    } else if (bcol >= 4096) {
      if (c0 < 16) {
#pragma unroll
        for (int ai = 0; ai < 2; ++ai)
#pragma unroll
          for (int m = 0; m < 4; ++m)
            *(f32x4*)(p.GBA + (size_t)(brow + ai * 128 + m * 16 + r0) * 16 + c0) = acc[ai][0][m][0];
      }
    } else {
      __half* base;
      int ld;
      if (bcol < 1024) {
        base = p.NAP + bcol; ld = 1536;
      } else if (bcol < 2048) {
        base = p.NAP + (bcol - 512); ld = 1536;
      } else if (bcol < 3584) {
        base = p.GQ + (bcol - 2048); ld = 1536;
      } else {
        base = p.GZ + (bcol - 3584); ld = 512;
      }
#pragma unroll
      for (int ai = 0; ai < 2; ++ai)
#pragma unroll
        for (int m = 0; m < 4; ++m) {
          __half* rowp = base + (size_t)(brow + ai * 128 + m * 16 + r0) * ld + c0;
#pragma unroll
          for (int bj = 0; bj < 2; ++bj)
#pragma unroll
            for (int n = 0; n < 2; ++n) store_h4(rowp + bj * 128 + n * 16, acc[ai][bj][m][n]);
        }
    }
  };
  if (first) {
    gemm_mfma<65, 15, 2, 1024, 16, 1>(p.H, p.WtI, shm, tid, b0, nb, epi);
  } else {
    gemm_mfma<65, 1, 0, 81, 0, 1>(p.H, p.WtI, shm, tid, b0, nb, epi);
  }
}

__device__ void phaseD_gdnpre(const Params& p, int tid) {
  const int lane = tid & 63;
  const int gw = blockIdx.x * NWV + (tid >> 6);
  const int nw3 = (gridDim.x * NWV) / 3;
  const int third = gw % 3, slot = gw / 3;
  if (slot >= nw3) return;
  const int c16 = lane & 15;
  const int axis = c16 >> 3, hq = c16 & 3;
  const bool first = (c16 & 4) == 0;
  const int ch = third * 512 + lane * 8;
  float wv[5][8];
#pragma unroll
  for (int j = 0; j < 5; ++j) {
    const f32x4 w0 = *(const f32x4*)(p.conv_w + j * 1536 + ch), w1 = *(const f32x4*)(p.conv_w + j * 1536 + ch + 4);
#pragma unroll
    for (int e = 0; e < 4; ++e) {
      wv[j][e] = w0[e];
      wv[j][4 + e] = w1[e];
    }
  }
  const float dtb = (lane < 8) ? p.dt_bias[lane] : 0.f, aexp = (lane < 8) ? -expf(p.A_log[lane]) : 0.f;
  for (int r0 = slot; r0 < LT; r0 += 2 * nw3) {
    f16x8 xv[2][5];
    float msk[2][5];
    f32x4 cs4[2][4];
    float gb[2], ga[2];
#pragma unroll
    for (int u = 0; u < 2; ++u) {
      const int r = min(r0 + u * nw3, LT - 1);
      const int pos = (r < L) ? r : r - L, len = (r < L) ? L : CTX, base = (r < L) ? 0 : L;
#pragma unroll
      for (int j = 0; j < 5; ++j) {
        const int pp = pos + j - 2;
        const bool ok = (pp >= 0 && pp < len);
        msk[u][j] = ok ? 1.f : 0.f;
        const f16x8 xl = *(const f16x8*)(p.GQ + (size_t)(base + min(max(pp, 0), len - 1)) * 1536 + ch);
        xv[u][j] = ok ? xl : (f16x8){};
      }
      const int tr = (axis == 0) ? (pos / GW) : (256 + pos % GW);
      const f32x4* csp = (const f32x4*)(p.ROPE + (size_t)(tr * 32 + hq * 8) * 2);
#pragma unroll
      for (int e = 0; e < 4; ++e) cs4[u][e] = csp[e];
      gb[u] = (lane < 8) ? p.GBA[(size_t)r * 16 + lane] : 0.f;
      ga[u] = (lane < 8) ? p.GBA[(size_t)r * 16 + 8 + lane] : 0.f;
    }
#pragma unroll
    for (int u = 0; u < 2; ++u) {
      const int r = r0 + u * nw3;
      if (r >= LT) break;
      float a[8];
#pragma unroll
      for (int e = 0; e < 8; ++e) a[e] = 0.f;
#pragma unroll
      for (int j = 0; j < 5; ++j)
#pragma unroll
        for (int e = 0; e < 8; ++e) a[e] += wv[j][e] * (float)xv[u][j][e];
#pragma unroll
      for (int e = 0; e < 8; ++e) a[e] = siluf(a[e]);
      if (third < 2) {
        float ss = 0.f;
#pragma unroll
        for (int e = 0; e < 8; ++e) ss += a[e] * a[e];
        ss += __shfl_xor(ss, 1, 64);
        ss += __shfl_xor(ss, 2, 64);
        ss += __shfl_xor(ss, 4, 64);
        ss += __shfl_xor(ss, 8, 64);
        const float inv = rsqrtf(ss + EPS);
#pragma unroll
        for (int e = 0; e < 8; ++e) a[e] *= inv;
        if (r < L) {
#pragma unroll
          for (int e = 0; e < 8; ++e) {
            const float other = __shfl_xor(a[e], 4, 64);
            const float cc = cs4[u][e >> 1][(e & 1) * 2], sn = cs4[u][e >> 1][(e & 1) * 2 + 1];
            a[e] = first ? (a[e] * cc - other * sn) : (a[e] * cc + other * sn);
          }
        }
      }
      {
        __half2 h[4];
#pragma unroll
        for (int e = 0; e < 4; ++e) h[e] = __floats2half2_rn(a[2 * e], a[2 * e + 1]);
        *(uint4*)(p.QKV + (size_t)r * 1536 + ch) = *(uint4*)h;
      }
      if (third == 0 && lane < 8) {
        const float beta = __builtin_amdgcn_rcpf(1.f + __expf(-gb[u]));
        const float xx = ga[u] + dtb;
        const float sp = (xx > 20.f) ? xx : log1pf(expf(xx));
        p.BETA[(size_t)r * 8 + lane] = beta;
        p.GG[(size_t)r * 8 + lane] = aexp * sp;
      }
    }
  }
}

#define MFMA16(a, b, c) __builtin_amdgcn_mfma_f32_16x16x32_f16(a, b, c, 0, 0, 0)
__device__ void phaseNA(const Params& p, float* smem, int tid, int b0, int nb) {
  const int lane = tid & 63, w = tid >> 6, fr = lane & 15, fq = lane >> 4;
  const int t = w & 3, g = w >> 2;
  float* rp = smem;
  float* xch = smem + 512;
  int hcur = -1;
  for (int item = (int)blockIdx.x - b0; item < 2048; item += nb) {
    const int r = item >> 3, h = item & 7;
    if (h != hcur) {
      __syncthreads();
      for (int i = tid; i < 465; i += NT) rp[i] = p.rpb[h * 465 + i];
      hcur = h;
      __syncthreads();
    }
    const int rs = min(max(r - 4, 0), 248);
    const int ws = (t == 0) ? 0 : (t == 1) ? 8 : (t == 2) ? 24 : 32;
    const int c = 16 * t + fr;
    const int cs = min(max(c - 8, 0), 48);
    const int tq = r * 64 + c;
    f16x8 qf[2];
    qf[0] = *(const f16x8*)(p.NAP + (size_t)tq * 1536 + h * 64 + 8 * fq);
    qf[1] = *(const f16x8*)(p.NAP + (size_t)tq * 1536 + h * 64 + 32 + 8 * fq);
    f32x4 s[16];
    {
      f16x8 kb[32];
#pragma unroll
      for (int nt = 0; nt < 16; ++nt) {
        const int tb = (g == 0) ? (rs + (nt >> 1)) * 64 + ws : L + 32 * (nt >> 1);
        const int tokr = tb + 8 * (fr >> 2) + 4 * (nt & 1) + (fr & 3);
        const __half* kp = p.NAP + (size_t)tokr * 1536 + 512 + h * 64 + 8 * fq;
        kb[2 * nt] = *(const f16x8*)kp;
        kb[2 * nt + 1] = *(const f16x8*)(kp + 32);
      }
#pragma unroll
      for (int nt = 0; nt < 16; ++nt) {
        f32x4 acc = {0.f, 0.f, 0.f, 0.f};
        acc = MFMA16(kb[2 * nt], qf[0], acc);
        acc = MFMA16(kb[2 * nt + 1], qf[1], acc);
        s[nt] = acc;
      }
    }
    f16x8 vb[32];
#pragma unroll
    for (int ks = 0; ks < 8; ++ks) {
      const int tokA = ((g == 0) ? (rs + ks) * 64 + ws : L + 32 * ks) + 8 * fq;
#pragma unroll
      for (int nd = 0; nd < 4; ++nd) vb[4 * ks + nd] = *(const f16x8*)(p.VT + (size_t)(h * 64 + 16 * nd + fr) * LT + tokA);
    }
    float m = -1e30f;
#pragma unroll
    for (int nt = 0; nt < 16; ++nt)
#pragma unroll
      for (int rr = 0; rr < 4; ++rr) {
        float v = s[nt][rr] * 0.125f;
        if (g == 0) {
          const int i = nt >> 1, kc = ws + 8 * fq + 4 * (nt & 1) + rr;
          const bool ok = (kc >= cs) && (kc < cs + 16);
          const float bias = rp[(rs + i - r + 7) * 31 + min(max(kc - c + 15, 0), 30)];
          v = ok ? v + bias : -1e30f;
        }
        s[nt][rr] = v;
        m = fmaxf(m, v);
      }
    m = fmaxf(m, __shfl_xor(m, 16, 64));
    m = fmaxf(m, __shfl_xor(m, 32, 64));
    float l = 0.f;
#pragma unroll
    for (int nt = 0; nt < 16; ++nt)
#pragma unroll
      for (int rr = 0; rr < 4; ++rr) {
        const float e = __expf(s[nt][rr] - m);
        s[nt][rr] = e;
        l += e;
      }
    l += __shfl_xor(l, 16, 64);
    l += __shfl_xor(l, 32, 64);
    f32x4 o[4];
#pragma unroll
    for (int nd = 0; nd < 4; ++nd) o[nd] = (f32x4){0.f, 0.f, 0.f, 0.f};
#pragma unroll
    for (int ks = 0; ks < 8; ++ks) {
      f16x8 pf;
#pragma unroll
      for (int j = 0; j < 4; ++j) {
        pf[j] = (_Float16)s[2 * ks][j];
        pf[4 + j] = (_Float16)s[2 * ks + 1][j];
      }
#pragma unroll
      for (int nd = 0; nd < 4; ++nd) {
        o[nd] = MFMA16(vb[4 * ks + nd], pf, o[nd]);
      }
    }
    float* xc = xch + (t * 64 + lane) * 18;
    if (g == 1) {
      xc[0] = m;
      xc[1] = l;
#pragma unroll
      for (int nd = 0; nd < 4; ++nd)
#pragma unroll
        for (int rr = 0; rr < 4; ++rr) xc[2 + nd * 4 + rr] = o[nd][rr];
    }
    __syncthreads();
    if (g == 0) {
      const float m1 = xc[0], l1 = xc[1];
      const float mm = fmaxf(m, m1);
      const float a0 = __expf(m - mm), a1 = __expf(m1 - mm);
      const float inv = 1.f / (l * a0 + l1 * a1);
#pragma unroll
      for (int nd = 0; nd < 4; ++nd) {
        const f16x4 z = *(const f16x4*)(p.NAP + (size_t)tq * 1536 + 1024 + h * 64 + 16 * nd + 4 * fq);
        f32x4 ov;
#pragma unroll
        for (int rr = 0; rr < 4; ++rr) ov[rr] = (o[nd][rr] * a0 + xc[2 + nd * 4 + rr] * a1) * inv * siluf((float)z[rr]);
        store_h4(p.MIX + (size_t)tq * 1024 + h * 64 + 16 * nd + 4 * fq, ov);
      }
    }
    __syncthreads();
  }
}

__device__ inline int seqrow(int dir, int n) {
  if (dir == 0) return (n < CTX) ? (L + n) : (n - CTX);
  return (n < CTX) ? (L + CTX - 1 - n) : (L - 1 - (n - CTX));
}
constexpr int NCH = LT / 64;
constexpr int E1_SPLIT = 71;

__device__ void phaseE1(const Params& p, float* smem, int tid, int b0, int nb, int idx_lo, int idx_hi) {
  const int lane = tid & 63, w = tid >> 6, fr = lane & 15, fq = lane >> 4;
  float* Am = smem + w * (64 * 68);
  float* gs = smem + 8 * (64 * 68) + w * 128;
  const float scale = 0.08838834764831845f;
  for (int idx = idx_lo + ((int)blockIdx.x - b0) + w * nb; idx < idx_hi; idx += nb * NWV) {
    const int chain = idx & 7, n = idx >> 3;
    const int item = chain * NCH + n;
    const int dir = chain >> 2, hd = chain & 3;
    const int row_s = seqrow(dir, n * 64 + lane);
    const float g = p.GG[(size_t)row_s * 8 + dir * 4 + hd], beta = p.BETA[(size_t)row_s * 8 + dir * 4 + hd];
    float gc = g;
#pragma unroll
    for (int o = 1; o < 64; o <<= 1) {
      float t = __shfl_up(gc, o, 64);
      if (lane >= o) gc += t;
    }
    const float gl = __shfl(gc, 63, 64);
    {
      const float e = __expf(gc);
      float* sc = p.SC + (size_t)item * 320;
      sc[lane] = beta * e;
      sc[64 + lane] = __expf(gl - gc);
      sc[128 + lane] = scale * e;
      sc[192 + lane] = beta;
      if (lane == 0) sc[256] = __expf(gl);
    }
    gs[lane] = gc;
    gs[64 + lane] = beta;
    f16x8 kf[4][4];
    auto loadk = [&]() {
#pragma unroll
      for (int m = 0; m < 4; ++m) {
        const int row = seqrow(dir, n * 64 + 16 * m + fr);
        const __half* base = p.QKV + (size_t)row * 1536 + 512 + hd * 128 + 8 * fq;
#pragma unroll
        for (int kk = 0; kk < 4; ++kk) kf[m][kk] = *(const f16x8*)(base + 32 * kk);
      }
    };
    loadk();
    __builtin_amdgcn_wave_barrier();
#pragma unroll
    for (int mi = 0; mi < 4; ++mi) {
      const f32x4 gci = *(const f32x4*)(gs + 16 * mi + 4 * fq);
      const f32x4 bti = *(const f32x4*)(gs + 64 + 16 * mi + 4 * fq);
#pragma unroll
      for (int nj = 0; nj <= mi; ++nj) {
        f32x4 acc = {0.f, 0.f, 0.f, 0.f};
#pragma unroll
        for (int kk = 0; kk < 4; ++kk) acc = MFMA16(kf[mi][kk], kf[nj][kk], acc);
        const int j = 16 * nj + fr;
        const float gcj = gs[j];
#pragma unroll
        for (int r = 0; r < 4; ++r) {
          const int i = 16 * mi + 4 * fq + r;
          float val = bti[r] * acc[r] * __expf(fminf(gci[r] - gcj, 0.f));
          Am[i * 68 + j] = (i > j) ? val : 0.f;
        }
      }
    }
    __builtin_amdgcn_wave_barrier();
    {
      int lane_i = lane;
      asm volatile("" : "+v"(lane_i));
      float Ar[64], Tr[64];
#pragma unroll
      for (int j4 = 0; j4 < 16; ++j4) {
        const f32x4 av = *(const f32x4*)(Am + lane_i * 68 + 4 * j4);
#pragma unroll
        for (int e = 0; e < 4; ++e) Ar[4 * j4 + e] = (4 * j4 + e < lane_i) ? av[e] : 0.f;
      }
#pragma unroll
      for (int c = 0; c < 64; ++c) Tr[c] = (c == lane_i) ? 1.f : 0.f;
#pragma unroll
      for (int j = 0; j < 63; ++j) {
#pragma unroll
        for (int c = 0; c <= j; ++c) {
          const float tjc = __builtin_bit_cast(float, __builtin_amdgcn_readlane(__builtin_bit_cast(int, Tr[c]), j));
          Tr[c] -= Ar[j] * tjc;
        }
      }
      __half* Tb = p.TB + (size_t)item * 4096 + lane_i * 64;
#pragma unroll
      for (int c8 = 0; c8 < 8; ++c8) {
        __half2 h[4];
#pragma unroll
        for (int e = 0; e < 4; ++e) h[e] = __floats2half2_rn(Tr[8 * c8 + 2 * e], Tr[8 * c8 + 2 * e + 1]);
        *(uint4*)(Tb + 8 * c8) = *(uint4*)h;
      }
    }
    asm volatile("" ::: "memory");
    loadk();
    __half* Qb = p.QKM + (size_t)item * 4096;
#pragma unroll
    for (int mi = 0; mi < 4; ++mi) {
      f16x8 qf[4];
      {
        const int row = seqrow(dir, n * 64 + 16 * mi + fr);
        const __half* base = p.QKV + (size_t)row * 1536 + hd * 128 + 8 * fq;
#pragma unroll
        for (int kk = 0; kk < 4; ++kk) qf[kk] = *(const f16x8*)(base + 32 * kk);
      }
      const int i = 16 * mi + fr;
      const float gci = gs[i];
#pragma unroll
      for (int nj = 0; nj < 4; ++nj) {
        f32x4 acc = {0.f, 0.f, 0.f, 0.f};
        if (nj <= mi) {
#pragma unroll
          for (int kk = 0; kk < 4; ++kk) acc = MFMA16(kf[nj][kk], qf[kk], acc);
          const f32x4 gcj = *(const f32x4*)(gs + 16 * nj + 4 * fq);
#pragma unroll
          for (int r = 0; r < 4; ++r) {
            const int j = 16 * nj + 4 * fq + r;
            float val = acc[r] * scale * __expf(fminf(gci - gcj[r], 0.f));
            acc[r] = (i >= j) ? val : 0.f;
          }
        }
        store_h4(Qb + i * 64 + 16 * nj + 4 * fq, acc);
      }
    }
    __builtin_amdgcn_wave_barrier();
  }
}

__device__ void phaseE2(const Params& p, float* smem, int tid) {
  const int chain = blockIdx.x & 7, slice = blockIdx.x >> 3, dir = chain >> 2, hd = chain & 3, e0 = slice * 16;
  const int lane = tid & 63, w = __builtin_amdgcn_readfirstlane(tid >> 6), fr = lane & 15, fq = lane >> 4;
  char* lds = (char*)smem;
  constexpr int SLOT = 56576, O_K = 0, O_Q = 17408, O_T = 34816, O_QK = 44032, O_V = 53248, O_SC = 55296;
  constexpr int O_ST = 2 * SLOT;
  constexpr int O_VN = O_ST + 3 * 4352;
  constexpr int O_RHS = O_VN + 2 * 2304;
  constexpr int O_VND = O_RHS + 2304;
  constexpr int O_DMY = O_VND + 2304;
  static_assert(O_DMY + 512 * 16 <= LDS_BYTES, "scan LDS map");
  __half* Od = dir ? p.OB : p.OF;
  auto relrow = [&](int pos) { return dir ? 63 - pos : pos; };
  auto rowbase = [&](int m) { return dir == 0 ? (m < 4 ? L + 64 * m : 64 * (m - 4)) : (m < 4 ? L + 192 - 64 * m : L - 64 * (m - 3)); };

  for (int i = tid; i < 16 * 136; i += NT) ((__half*)(lds + O_ST))[i] = __float2half(0.f);

  if (w >= 2) {
    unsigned goff0 = 0, loff0 = 0, goff1 = 0, loff1 = 0, goff2 = 0, loff2 = 0, goff3 = 0, loff3 = 0, goff4 = 0, loff4 = 0, goff5 = 0, loff5 = 0, goff6 = 0, loff6 = 0, goff7 = 0, loff7 = 0, goff8 = 0, loff8 = 0, goff9 = 0, loff9 = 0, goff10 = 0, loff10 = 0, goff11 = 0, loff11 = 0;
    auto piece = [&](int j, unsigned& g, unsigned& l) {
      g = 0;
      l = O_DMY + tid * 16;
      if (w <= 5 && j < 8) {
        const int f = ((tid - 128) & 127) + 128 * j, pos = f >> 4, c16 = f & 15;
        g = relrow(pos) * 3072u + ((w <= 3 ? 512 : 0) + hd * 128 + c16 * 8) * 2u;
        l = (w <= 3 ? O_K : O_Q) + pos * 272 + c16 * 16;
      } else if (w >= 6 && j < 8) {
        const int f = lane + 64 * j;
        if (!((f >> 3) < 32 && (f & 7) >= 4)) {
          g = f * 16u;
          l = (w == 6 ? O_T : O_QK) + (f >> 3) * 144 + (f & 7) * 16;
        }
      } else if (w == 7 && j < 10) {
        const int f = lane + 64 * (j - 8);
        g = relrow(f >> 1) * 3072u + (1024 + hd * 128 + e0 + (f & 1) * 8) * 2u;
        l = O_V + (f >> 1) * 32 + (f & 1) * 16;
      } else if (w == 7) {
        const int f = lane + 64 * (j - 10);
        if (f < 80) {
          g = f * 16u;
          l = O_SC + f * 16;
        }
      }
    };
    piece(0, goff0, loff0);
    piece(1, goff1, loff1);
    piece(2, goff2, loff2);
    piece(3, goff3, loff3);
    piece(4, goff4, loff4);
    piece(5, goff5, loff5);
    piece(6, goff6, loff6);
    piece(7, goff7, loff7);
    piece(8, goff8, loff8);
    piece(9, goff9, loff9);
    piece(10, goff10, loff10);
    piece(11, goff11, loff11);
    uint4 R0_0 = {}, R0_1 = {}, R0_2 = {}, R0_3 = {}, R0_4 = {}, R0_5 = {}, R0_6 = {}, R0_7 = {}, R0_8 = {}, R0_9 = {}, R0_10 = {}, R0_11 = {}, R1_0 = {}, R1_1 = {}, R1_2 = {}, R1_3 = {}, R1_4 = {}, R1_5 = {}, R1_6 = {}, R1_7 = {}, R1_8 = {}, R1_9 = {}, R1_10 = {}, R1_11 = {}, R2_0 = {}, R2_1 = {}, R2_2 = {}, R2_3 = {}, R2_4 = {}, R2_5 = {}, R2_6 = {}, R2_7 = {}, R2_8 = {}, R2_9 = {}, R2_10 = {}, R2_11 = {};
#define LD_ISSUE(S, mm)                                                                                   \
  do {                                                                                                    \
    const int m_ = min((mm), NCH - 1);                                                                    \
    const size_t item_ = (size_t)chain * NCH + m_;                                                        \
    const char* b0_ = (const char*)(p.QKV + (size_t)rowbase(m_) * 1536);                                  \
    const char* bA_ = (w <= 5) ? b0_ : (w == 6 ? (const char*)(p.TB + item_ * 4096) : (const char*)(p.QKM + item_ * 4096)); \
    const char* bS_ = (w == 7) ? (const char*)(p.SC + item_ * 320) : b0_;                                 \
    R##S##_0 = *(const uint4*)(bA_ + goff0);                                                         \
    R##S##_1 = *(const uint4*)(bA_ + goff1);                                                         \
    R##S##_2 = *(const uint4*)(bA_ + goff2);                                                         \
    R##S##_3 = *(const uint4*)(bA_ + goff3);                                                         \
    R##S##_4 = *(const uint4*)(bA_ + goff4);                                                         \
    R##S##_5 = *(const uint4*)(bA_ + goff5);                                                         \
    R##S##_6 = *(const uint4*)(bA_ + goff6);                                                         \
    R##S##_7 = *(const uint4*)(bA_ + goff7);                                                         \
    R##S##_8 = *(const uint4*)(b0_ + goff8);                                                         \
    R##S##_9 = *(const uint4*)(b0_ + goff9);                                                         \
    R##S##_10 = *(const uint4*)(bS_ + goff10);                                                         \
    R##S##_11 = *(const uint4*)(bS_ + goff11);                                                         \
  } while (0)
#define LD_WRITE(S, mm)                                                                                   \
  do {                                                                                                    \
    char* sl_ = lds + ((mm)&1) * SLOT;                                                                    \
    *(uint4*)((loff0 >= (unsigned)O_DMY ? lds : sl_) + loff0) = R##S##_0;                           \
    *(uint4*)((loff1 >= (unsigned)O_DMY ? lds : sl_) + loff1) = R##S##_1;                           \
    *(uint4*)((loff2 >= (unsigned)O_DMY ? lds : sl_) + loff2) = R##S##_2;                           \
    *(uint4*)((loff3 >= (unsigned)O_DMY ? lds : sl_) + loff3) = R##S##_3;                           \
    *(uint4*)((loff4 >= (unsigned)O_DMY ? lds : sl_) + loff4) = R##S##_4;                           \
    *(uint4*)((loff5 >= (unsigned)O_DMY ? lds : sl_) + loff5) = R##S##_5;                           \
    *(uint4*)((loff6 >= (unsigned)O_DMY ? lds : sl_) + loff6) = R##S##_6;                           \
    *(uint4*)((loff7 >= (unsigned)O_DMY ? lds : sl_) + loff7) = R##S##_7;                           \
    if (w == 7) {                      \
      *(uint4*)((loff8 >= (unsigned)O_DMY ? lds : sl_) + loff8) = R##S##_8;                         \
      *(uint4*)((loff9 >= (unsigned)O_DMY ? lds : sl_) + loff9) = R##S##_9;                         \
      *(uint4*)((loff10 >= (unsigned)O_DMY ? lds : sl_) + loff10) = R##S##_10;                         \
      *(uint4*)((loff11 >= (unsigned)O_DMY ? lds : sl_) + loff11) = R##S##_11;                         \
    }                                                                                                     \
  } while (0)
    LD_ISSUE(0, 0);
    LD_ISSUE(1, 1);
    LD_ISSUE(2, 2);
    LD_WRITE(0, 0);
    __syncthreads();
    static_assert(NCH % 3 == 2, "loader tail assumes NCH = 3k + 2");
    for (int n = 0; n < NCH - 2; n += 3) {
      if (n == E1_SPLIT - 8) {
        if (lane == 0) {
          const unsigned want = gridDim.x - 64;
          unsigned spins = 0;
          while (__hip_atomic_load(p.E1DONE, __ATOMIC_RELAXED, __HIP_MEMORY_SCOPE_AGENT) < want && ++spins < (1u << 24)) __builtin_amdgcn_s_sleep(2);
        }
        __builtin_amdgcn_fence(__ATOMIC_ACQUIRE, "agent");
        asm volatile("s_waitcnt vmcnt(0)" ::: "memory");
      }
      LD_ISSUE(0, n + 3); LD_WRITE(1, n + 1); __syncthreads();
      LD_ISSUE(1, n + 4); LD_WRITE(2, n + 2); __syncthreads();
      LD_ISSUE(2, n + 5); LD_WRITE(0, n + 3); __syncthreads();
    }
    LD_WRITE(1, NCH - 1); __syncthreads();
    __syncthreads();
#undef LD_ISSUE
#undef LD_WRITE
  } else if (w == 0) {
    f32x4 Sacc[8];
#pragma unroll
    for (int d = 0; d < 8; ++d) Sacc[d] = (f32x4){0.f, 0.f, 0.f, 0.f};
    __half* rhsT = (__half*)(lds + O_RHS);
    __half* vndT = (__half*)(lds + O_VND);
    __syncthreads();
    int n3 = 0;
    for (int n = 0; n < NCH; ++n) {
      const char* sl = lds + (n & 1) * SLOT;
      const __half* kc = (const __half*)(sl + O_K);
      const __half* tc = (const __half*)(sl + O_T);
      const float* sc = (const float*)(sl + O_SC);
      const __half* STc = (const __half*)(lds + O_ST + n3 * 4352);
      const int n3n = (n3 == 2) ? 0 : n3 + 1;
      __half* STn = (__half*)(lds + O_ST + n3n * 4352);
      __half* vnT = (__half*)(lds + O_VN + (n & 1) * 2304);
      f16x8 Sf[4], kfr[4][4], tf[6];
      f32x4 be[4], bt[4], dd[4];
      unsigned short uv[4][4];
#pragma unroll
      for (int kk = 0; kk < 4; ++kk) Sf[kk] = *(const f16x8*)(STc + fr * 136 + 32 * kk + 8 * fq);
#pragma unroll
      for (int m = 0; m < 4; ++m) {
#pragma unroll
        for (int kk = 0; kk < 4; ++kk) kfr[m][kk] = *(const f16x8*)(kc + (16 * m + fr) * 136 + 32 * kk + 8 * fq);
        be[m] = *(const f32x4*)(sc + 16 * m + 4 * fq);
        bt[m] = *(const f32x4*)(sc + 192 + 16 * m + 4 * fq);
        dd[m] = *(const f32x4*)(sc + 64 + 16 * m + 4 * fq);
        const unsigned short* vp = (const unsigned short*)(sl + O_V) + (16 * m + 4 * fq) * 16 + fr;
        uv[m][0] = vp[0]; uv[m][1] = vp[16]; uv[m][2] = vp[32]; uv[m][3] = vp[48];
      }
      tf[0] = *(const f16x8*)(tc + (0 + fr) * 72 + 8 * fq);
      tf[1] = *(const f16x8*)(tc + (16 + fr) * 72 + 8 * fq);
      tf[2] = *(const f16x8*)(tc + (32 + fr) * 72 + 8 * fq);
      tf[3] = *(const f16x8*)(tc + (32 + fr) * 72 + 32 + 8 * fq);
      tf[4] = *(const f16x8*)(tc + (48 + fr) * 72 + 8 * fq);
      tf[5] = *(const f16x8*)(tc + (48 + fr) * 72 + 32 + 8 * fq);
      const float glast = sc[256];
      __builtin_amdgcn_sched_barrier(0);
      f32x4 ks[4];
#pragma unroll
      for (int m = 0; m < 4; ++m) ks[m] = (f32x4){0.f, 0.f, 0.f, 0.f};
#pragma unroll
      for (int kk = 0; kk < 4; ++kk)
#pragma unroll
        for (int m = 0; m < 4; ++m) ks[m] = MFMA16(kfr[m][kk], Sf[kk], ks[m]);
#pragma unroll
      for (int m = 0; m < 4; ++m) {
        f32x4 rhs;
#pragma unroll
        for (int r = 0; r < 4; ++r) rhs[r] = bt[m][r] * __half2float(__ushort_as_half(uv[m][r])) - be[m][r] * ks[m][r];
        store_h4(rhsT + fr * 72 + 16 * m + 4 * fq, rhs);
      }
      f16x8 rf[2];
      rf[0] = *(const f16x8*)(rhsT + fr * 72 + 8 * fq);
      rf[1] = *(const f16x8*)(rhsT + fr * 72 + 32 + 8 * fq);
      f16x8 ktf[8][2];
#pragma unroll
      for (int d = 0; d < 8; ++d)
#pragma unroll
        for (int kk = 0; kk < 2; ++kk) {
          const __half* kb = kc + (32 * kk + 8 * fq + (fr >> 2)) * 136 + 16 * d + 4 * (fr & 3);
          const h16x4 lo = __builtin_amdgcn_ds_read_tr16_b64_v4f16((__attribute__((address_space(3))) h16x4*)(kb));
          const h16x4 hi = __builtin_amdgcn_ds_read_tr16_b64_v4f16((__attribute__((address_space(3))) h16x4*)(kb + 4 * 136));
          const f16x4 lo4 = __builtin_bit_cast(f16x4, lo), hi4 = __builtin_bit_cast(f16x4, hi);
          ktf[d][kk] = (f16x8){lo4[0], lo4[1], lo4[2], lo4[3], hi4[0], hi4[1], hi4[2], hi4[3]};
        }
      __builtin_amdgcn_sched_barrier(0);
      f32x4 vnv[4];
      vnv[0] = MFMA16(tf[0], rf[0], ((f32x4){0.f, 0.f, 0.f, 0.f}));
      vnv[1] = MFMA16(tf[1], rf[0], ((f32x4){0.f, 0.f, 0.f, 0.f}));
      vnv[2] = MFMA16(tf[2], rf[0], ((f32x4){0.f, 0.f, 0.f, 0.f}));
      vnv[3] = MFMA16(tf[4], rf[0], ((f32x4){0.f, 0.f, 0.f, 0.f}));
      vnv[2] = MFMA16(tf[3], rf[1], vnv[2]);
      vnv[3] = MFMA16(tf[5], rf[1], vnv[3]);
#pragma unroll
      for (int m = 0; m < 4; ++m) {
        store_h4(vnT + fr * 72 + 16 * m + 4 * fq, vnv[m]);
        f32x4 vd;
#pragma unroll
        for (int r = 0; r < 4; ++r) vd[r] = vnv[m][r] * dd[m][r];
        store_h4(vndT + fr * 72 + 16 * m + 4 * fq, vd);
      }
      f16x8 vdf[2];
      vdf[0] = *(const f16x8*)(vndT + fr * 72 + 8 * fq);
      vdf[1] = *(const f16x8*)(vndT + fr * 72 + 32 + 8 * fq);
#pragma unroll
      for (int d = 0; d < 8; ++d)
#pragma unroll
        for (int r = 0; r < 4; ++r) Sacc[d][r] *= glast;
      __builtin_amdgcn_sched_barrier(0);
#pragma unroll
      for (int kk = 0; kk < 2; ++kk)
#pragma unroll
        for (int d = 0; d < 8; ++d) Sacc[d] = MFMA16(ktf[d][kk], vdf[kk], Sacc[d]);
#pragma unroll
      for (int d = 0; d < 8; ++d) store_h4(STn + fr * 136 + 16 * d + 4 * fq, Sacc[d]);
      n3 = n3n;
      __syncthreads();
    }
  } else {
    f32x4 accq[4], sep[4];
    f16x8 qkp[4][2];
#pragma unroll
    for (int m = 0; m < 4; ++m) {
      accq[m] = (f32x4){0.f, 0.f, 0.f, 0.f};
      sep[m] = (f32x4){0.f, 0.f, 0.f, 0.f};
      qkp[m][0] = (f16x8){};
      qkp[m][1] = (f16x8){};
    }
    const unsigned ocol = (hd * 128 + e0 + fr) * 2u;
    auto emit = [&](int np) {
      const __half* vnT = (const __half*)(lds + O_VN + (np & 1) * 2304);
      f16x8 vf[2];
      vf[0] = *(const f16x8*)(vnT + fr * 72 + 8 * fq);
      vf[1] = *(const f16x8*)(vnT + fr * 72 + 32 + 8 * fq);
      char* ob = (char*)(Od + (size_t)rowbase(np) * 512);
      __builtin_amdgcn_sched_barrier(0);
      f32x4 o[4];
#pragma unroll
      for (int m = 0; m < 4; ++m)
#pragma unroll
        for (int r = 0; r < 4; ++r) o[m][r] = sep[m][r] * accq[m][r];
#pragma unroll
      for (int m = 0; m < 4; ++m) o[m] = MFMA16(qkp[m][0], vf[0], o[m]);
      o[2] = MFMA16(qkp[2][1], vf[1], o[2]);
      o[3] = MFMA16(qkp[3][1], vf[1], o[3]);
      if (np >= 4) {
#pragma unroll
        for (int m = 0; m < 4; ++m)
#pragma unroll
          for (int r = 0; r < 4; ++r) *(__half*)(ob + relrow(16 * m + 4 * fq + r) * 1024u + ocol) = __float2half(o[m][r]);
      }
    };
    __syncthreads();
    int n3 = 0;
    for (int n = 0; n < NCH; ++n) {
      const char* sl = lds + (n & 1) * SLOT;
      const __half* qc = (const __half*)(sl + O_Q);
      const __half* mc = (const __half*)(sl + O_QK);
      const float* sc = (const float*)(sl + O_SC);
      const __half* STc = (const __half*)(lds + O_ST + n3 * 4352);
      if (n > 0) emit(n - 1);
      f16x8 Sf[4], qfr[4][4];
#pragma unroll
      for (int kk = 0; kk < 4; ++kk) Sf[kk] = *(const f16x8*)(STc + fr * 136 + 32 * kk + 8 * fq);
#pragma unroll
      for (int m = 0; m < 4; ++m) {
#pragma unroll
        for (int kk = 0; kk < 4; ++kk) qfr[m][kk] = *(const f16x8*)(qc + (16 * m + fr) * 136 + 32 * kk + 8 * fq);
        sep[m] = *(const f32x4*)(sc + 128 + 16 * m + 4 * fq);
        qkp[m][0] = *(const f16x8*)(mc + (16 * m + fr) * 72 + 8 * fq);
        qkp[m][1] = *(const f16x8*)(mc + (16 * m + fr) * 72 + 32 + 8 * fq);
      }
      __builtin_amdgcn_sched_barrier(0);
#pragma unroll
      for (int m = 0; m < 4; ++m) accq[m] = (f32x4){0.f, 0.f, 0.f, 0.f};
#pragma unroll
      for (int kk = 0; kk < 4; ++kk)
#pragma unroll
        for (int m = 0; m < 4; ++m) accq[m] = MFMA16(qfr[m][kk], Sf[kk], accq[m]);
      n3 = (n3 == 2) ? 0 : n3 + 1;
      __syncthreads();
    }
    emit(NCH - 1);
  }
}

__device__ void phaseF(const Params& p, int tid) {
  const int lane = tid & 63;
  const int gw = blockIdx.x * NWV + (tid >> 6);
  const int nw = gridDim.x * NWV;
  const f32x4 nw0 = *(const f32x4*)(p.gdn_norm_w + (lane & 15) * 8), nw1 = *(const f32x4*)(p.gdn_norm_w + (lane & 15) * 8 + 4);
  for (int t0 = gw; t0 < L; t0 += 2 * nw) {
    f16x8 vf[2], vb[2], z[2];
#pragma unroll
    for (int u = 0; u < 2; ++u) {
      const size_t o = (size_t)min(t0 + u * nw, L - 1) * 512 + lane * 8;
      vf[u] = *(const f16x8*)(p.OF + o);
      vb[u] = *(const f16x8*)(p.OB + o);
      z[u] = *(const f16x8*)(p.GZ + o);
    }
#pragma unroll
    for (int u = 0; u < 2; ++u) {
      const int t = t0 + u * nw;
      if (t >= L) break;
      float v[8];
      float ss = 0.f;
#pragma unroll
      for (int e = 0; e < 8; ++e) {
        v[e] = (float)vf[u][e] + (float)vb[u][e];
        ss += v[e] * v[e];
      }
      ss += __shfl_xor(ss, 1, 64);
      ss += __shfl_xor(ss, 2, 64);
      ss += __shfl_xor(ss, 4, 64);
      ss += __shfl_xor(ss, 8, 64);
      const float inv = rsqrtf(ss * (1.f / 128.f) + EPS);
      __half2 h[4];
#pragma unroll
      for (int e = 0; e < 4; ++e) {
        const float w0 = (2 * e < 4) ? nw0[2 * e] : nw1[2 * e - 4], w1 = (2 * e + 1 < 4) ? nw0[2 * e + 1] : nw1[2 * e + 1 - 4];
        h[e] = __floats2half2_rn(v[2 * e] * inv * w0 * siluf((float)z[u][2 * e]), v[2 * e + 1] * inv * w1 * siluf((float)z[u][2 * e + 1]));
      }
      *(uint4*)(p.MIX + (size_t)t * 1024 + 512 + lane * 8) = *(uint4*)h;
    }
  }
}

__device__ void phaseG(const Params& p, __half* shm, int tid) {
  auto epi = [&](int brow, int bcol, const f32x4(&acc)[2][2][4][2], int r0, int c0) {
#pragma unroll
    for (int ai = 0; ai < 2; ++ai)
#pragma unroll
      for (int m = 0; m < 4; ++m) {
        __half* rowp = p.Y + (size_t)(brow + ai * 128 + m * 16 + r0) * 1024 + bcol + c0;
#pragma unroll
        for (int bj = 0; bj < 2; ++bj)
#pragma unroll
          for (int n = 0; n < 2; ++n) store_h4(rowp + bj * 128 + n * 16, acc[ai][bj][m][n]);
      }
  };
  gemm_mfma<64, 4, 0, 256, 0, 0>(p.MIX, p.WtO, shm, tid, 0, gridDim.x, epi);
}

__device__ void phaseH(const Params& p, int tid) {
  int lane = tid & 63;
  int gw = blockIdx.x * NWV + (tid >> 6);
  int nw = gridDim.x * NWV;
  float4 gg[2][2];
#pragma unroll
  for (int i = 0; i < 2; ++i)
#pragma unroll
    for (int hh = 0; hh < 2; ++hh) {
      const int j = i * 512 + lane * 8 + 4 * hh;
      const float4 g = *(const float4*)(p.g_post + j), gt = *(const float4*)(p.mod + 2048 + j);
      gg[i][hh] = make_float4(g.x * gt.x, g.y * gt.y, g.z * gt.z, g.w * gt.w);
    }
  for (int r0 = gw; r0 < L; r0 += 2 * nw) {
    f16x8 y[2][2];
    float4 xv[2][2][2];
#pragma unroll
    for (int u = 0; u < 2; ++u) {
      const int r = min(r0 + u * nw, L - 1);
#pragma unroll
      for (int i = 0; i < 2; ++i) {
        const int j = i * 512 + lane * 8;
        y[u][i] = *(const f16x8*)(p.Y + (size_t)r * D + j);
        xv[u][i][0] = *(const float4*)(p.x + (size_t)r * D + j);
        xv[u][i][1] = *(const float4*)(p.x + (size_t)r * D + j + 4);
      }
    }
#pragma unroll
    for (int u = 0; u < 2; ++u) {
      const int r = r0 + u * nw;
      if (r >= L) break;
      float ss = 0.f;
#pragma unroll
      for (int i = 0; i < 2; ++i)
#pragma unroll
        for (int e = 0; e < 8; ++e) ss += (float)y[u][i][e] * (float)y[u][i][e];
      ss = wsum(ss);
      const float inv = rsqrtf(ss * (1.f / D) + EPS);
#pragma unroll
      for (int i = 0; i < 2; ++i) {
        const int j = i * 512 + lane * 8;
#pragma unroll
        for (int hh = 0; hh < 2; ++hh) {
          const float4 x4 = xv[u][i][hh], f = gg[i][hh];
          float4 o;
          o.x = x4.x + f.x * ((float)y[u][i][4 * hh + 0] * inv);
          o.y = x4.y + f.y * ((float)y[u][i][4 * hh + 1] * inv);
          o.z = x4.z + f.z * ((float)y[u][i][4 * hh + 2] * inv);
          o.w = x4.w + f.w * ((float)y[u][i][4 * hh + 3] * inv);
          *(float4*)(p.out + (size_t)r * D + j + 4 * hh) = o;
        }
      }
    }
  }
}

__device__ __forceinline__ int fresh_tid(int wave_s) {
  int lane;
  asm volatile("v_mbcnt_lo_u32_b32 %0, -1, 0\n\tv_mbcnt_hi_u32_b32 %0, -1, %0" : "=v"(lane));
  return wave_s * 64 + lane;
}

constexpr size_t al256(size_t b) { return (b + 255) & ~(size_t)255; }
constexpr size_t OFF_MOD = 0;
constexpr size_t OFF_WTI = OFF_MOD + al256(2 * 3072 * 4);
constexpr size_t OFF_WTO = OFF_WTI + al256((size_t)NPAD * 1024 * 2);
constexpr size_t OFF_H = OFF_WTO + al256((size_t)1024 * 1024 * 2);
constexpr size_t OFF_NAP = OFF_H + al256((size_t)LT * 1024 * 2);
constexpr size_t OFF_VT = OFF_NAP + al256((size_t)LT * 1536 * 2);
constexpr size_t OFF_GQ = OFF_VT + al256((size_t)512 * LT * 2);
constexpr size_t OFF_GZ = OFF_GQ + al256((size_t)LT * 1536 * 2);
constexpr size_t OFF_GBA = OFF_GZ + al256((size_t)LT * 512 * 2);
constexpr size_t OFF_QKV = OFF_GBA + al256((size_t)LT * 16 * 4);
constexpr size_t OFF_BETA = OFF_QKV + al256((size_t)LT * 1536 * 2);
constexpr size_t OFF_GG = OFF_BETA + al256((size_t)LT * 8 * 4);
constexpr size_t OFF_QKM = OFF_GG + al256((size_t)LT * 8 * 4);
constexpr size_t OFF_SC = OFF_QKM + al256((size_t)8 * 260 * 4096 * 2);
constexpr size_t OFF_ROPE = OFF_SC + al256((size_t)8 * 260 * 320 * 4);
constexpr size_t OFF_BAR = OFF_ROPE + al256((size_t)320 * 32 * 2 * 4) + 256;
constexpr size_t WS_TOTAL = OFF_BAR + al256((size_t)3456 * 4);
static_assert(WS_TOTAL <= (size_t)256 * 1024 * 1024, "workspace map exceeds 256 MiB");

struct KArgs {
  const float* in[15];
  float* out;
  char* ws;
};

__device__ __forceinline__ Params make_params(const KArgs& a) {
  unsigned long long wsi = (unsigned long long)a.ws;
  asm volatile("" : "+s"(wsi));
  char* ws = (char*)(__attribute__((address_space(1))) char*)wsi;
  Params p;
  p.x = a.in[0]; p.c = a.in[1]; p.ctx = a.in[2]; p.c_ctx = a.in[3]; p.w_ada = a.in[4]; p.b_ada = a.in[5];
  p.g_pre = a.in[6]; p.g_post = a.in[7]; p.w_in = a.in[8]; p.conv_w = a.in[9]; p.rpb = a.in[10];
  p.A_log = a.in[11]; p.dt_bias = a.in[12]; p.gdn_norm_w = a.in[13]; p.w_out = a.in[14];
  p.out = a.out;
  p.mod = (float*)(ws + OFF_MOD);
  p.WtI = (__half*)(ws + OFF_WTI);
  p.WtO = (__half*)(ws + OFF_WTO);
  p.H = (__half*)(ws + OFF_H);
  p.MIX = p.H;
  p.NAP = (__half*)(ws + OFF_NAP);
  p.VT = (__half*)(ws + OFF_VT);
  p.Y = (__half*)(ws + OFF_NAP);
  p.GQ = (__half*)(ws + OFF_GQ);
  p.OF = p.GQ;
  p.OB = p.GQ + (size_t)L * 512;
  p.TB = p.GQ + (size_t)2 * L * 512;
  p.GZ = (__half*)(ws + OFF_GZ);
  p.GBA = (float*)(ws + OFF_GBA);
  p.QKV = (__half*)(ws + OFF_QKV);
  p.BETA = (float*)(ws + OFF_BETA);
  p.GG = (float*)(ws + OFF_GG);
  p.QKM = (__half*)(ws + OFF_QKM);
  p.SC = (float*)(ws + OFF_SC);
  p.ROPE = (float*)(ws + OFF_ROPE);
  p.E1DONE = (unsigned*)(ws + OFF_BAR) + 64;
  return p;
}

#define XB_TMO 128
#define XB_XCNT(j) (256 + 64 * (j))
#define XB_XSUB(j) (1280 + 64 * (j))
#define XB_XGEN(j) (2304 + 64 * (j))
#define XB_TOP 3328
#define XB_TOPGEN 3392
#define XCD_BAR_WORDS 3456
#define XB_SPIN_CAP (1u << 18)
#define XB_LAS __attribute__((address_space(3)))
__device__ __forceinline__ unsigned xb_ld(unsigned* p) { return __hip_atomic_load(p, __ATOMIC_RELAXED, __HIP_MEMORY_SCOPE_AGENT); }
__device__ __forceinline__ unsigned xb_add(unsigned* p, unsigned v) { return __hip_atomic_fetch_add(p, v, __ATOMIC_RELAXED, __HIP_MEMORY_SCOPE_AGENT); }
__device__ __forceinline__ unsigned xb_xcc_id() { return (unsigned)__builtin_amdgcn_s_getreg((3 << 11) | 20) & 0xFu; }
#define XB_SPIN(cond, bar)                                                   \
  do {                                                                       \
    unsigned _sp = 0;                                                        \
    while (cond) {                                                           \
      __builtin_amdgcn_s_sleep(1);                                           \
      if ((++_sp & 255u) == 0u) {                                            \
        if (xb_ld(&(bar)[XB_TMO])) break;                                    \
        if (_sp > XB_SPIN_CAP) {                                             \
          atomicAdd(&(bar)[XB_TMO], 1u);                                     \
          break;                                                             \
        }                                                                    \
      }                                                                      \
    }                                                                        \
  } while (0)
struct XcdBarrier {
  unsigned* bar;
  unsigned x;
  volatile XB_LAS unsigned* st;
};
__device__ __forceinline__ XcdBarrier xcd_barrier_post(unsigned* bar, volatile XB_LAS unsigned* st) {
  XcdBarrier b;
  b.bar = bar;
  b.x = xb_xcc_id();
  b.st = st;
  if (threadIdx.x == 0) (void)xb_add(&bar[XB_XCNT(b.x)], 1u);
  return b;
}
__device__ __forceinline__ void xcd_barrier_complete(unsigned* bar, unsigned x, unsigned& nloc, unsigned& nx) {
  const unsigned G = gridDim.x * gridDim.y * gridDim.z;
  unsigned sum, cnt, mine, sp = 0u;
  for (;;) {
    sum = 0u; cnt = 0u; mine = 0u;
#pragma unroll
    for (unsigned j = 0; j < 16; ++j) {
      const unsigned c = xb_ld(&bar[XB_XCNT(j)]);
      sum += c;
      cnt += (c > 0u) ? 1u : 0u;
      mine = (j == x) ? c : mine;
    }
    if (sum == G) break;
    __builtin_amdgcn_s_sleep(1);
    if ((++sp & 255u) == 0u) {
      if (xb_ld(&bar[XB_TMO])) break;
      if (sp > XB_SPIN_CAP) {
        atomicAdd(&bar[XB_TMO], 1u);
        break;
      }
    }
  }
  nloc = mine > 0u ? mine : 1u;
  nx = cnt > 0u ? cnt : 1u;
}
__device__ __forceinline__ void xcd_barrier(const XcdBarrier& b) {
  asm volatile("s_waitcnt vmcnt(0)" ::: "memory");
  __syncthreads();
  if (threadIdx.x == 0) {
    unsigned* bar = b.bar;
    __builtin_amdgcn_s_waitcnt(0);
    unsigned nloc = b.st[0], nx = b.st[1];
    if (nloc == 0u) {
      xcd_barrier_complete(bar, b.x, nloc, nx);
      b.st[0] = nloc;
      b.st[1] = nx;
    }
    const unsigned old = xb_add(&bar[XB_XSUB(b.x)], 1u);
    const unsigned gen = old / nloc;
    if (old + 1u == (gen + 1u) * nloc) {
      __builtin_amdgcn_fence(__ATOMIC_RELEASE, "agent");
      asm volatile("s_waitcnt vmcnt(0)" ::: "memory");
      const unsigned og = xb_add(&bar[XB_TOP], 1u);
      const unsigned tg = og / nx;
      if (og + 1u == (tg + 1u) * nx) xb_add(&bar[XB_TOPGEN], 1u);
      else XB_SPIN(xb_ld(&bar[XB_TOPGEN]) == tg, bar);
      __builtin_amdgcn_fence(__ATOMIC_ACQUIRE, "agent");
      xb_add(&bar[XB_XGEN(b.x)], 1u);
      asm volatile("s_waitcnt vmcnt(0)" ::: "memory");
    } else {
      XB_SPIN(xb_ld(&bar[XB_XGEN(b.x)]) == gen, bar);
      __builtin_amdgcn_fence(__ATOMIC_ACQUIRE, "agent");
      asm volatile("s_waitcnt vmcnt(0)" ::: "memory");
    }
  }
  __syncthreads();
}

__device__ __forceinline__ void grid_barrier(unsigned* ctr, unsigned target) {
  asm volatile("s_waitcnt vmcnt(0)" ::: "memory");
  __syncthreads();
  if (threadIdx.x == 0) {
    __builtin_amdgcn_fence(__ATOMIC_RELEASE, "agent");
    asm volatile("s_waitcnt vmcnt(0)" ::: "memory");
    __hip_atomic_fetch_add(ctr, 1u, __ATOMIC_RELAXED, __HIP_MEMORY_SCOPE_AGENT);
    unsigned spins = 0;
    while (__hip_atomic_load(ctr, __ATOMIC_RELAXED, __HIP_MEMORY_SCOPE_AGENT) < target && ++spins < (1u << 24))
      __builtin_amdgcn_s_sleep(1);
    __builtin_amdgcn_fence(__ATOMIC_ACQUIRE, "agent");
    asm volatile("s_waitcnt vmcnt(0)" ::: "memory");
  }
  __syncthreads();
}

template <int PH>
__device__ void run_phase(const KArgs& a, float* smem, int wave_s) {
  const int tid = fresh_tid(wave_s);
  const Params p = make_params(a);
  if constexpr (PH == 0) phaseA(p, smem, tid);
  if constexpr (PH == 1) phaseB(p, tid);
  if constexpr (PH == 2) phaseC(p, (__half*)smem, tid, true, 0, gridDim.x);
  if constexpr (PH == 3) phaseD_gdnpre(p, tid);
  if constexpr (PH == 4) {
    if (blockIdx.x < 81) {
      int tg = tid;
      asm volatile("" : "+v"(tg));
      phaseC(p, (__half*)smem, tg, false, 0, 81);
    } else {
      int te = tid;
      asm volatile("" : "+v"(te));
      phaseE1(p, smem, te, 81, gridDim.x - 81, 0, 8 * E1_SPLIT);
    }
  }
  if constexpr (PH == 8) {
    if (blockIdx.x < 64) {
      phaseE2(p, smem, tid);
    } else {
      phaseE1(p, smem, tid, 64, gridDim.x - 64, 8 * E1_SPLIT, 8 * NCH);
      asm volatile("s_waitcnt vmcnt(0)" ::: "memory");
      __syncthreads();
      if (tid == 0) {
        __builtin_amdgcn_fence(__ATOMIC_RELEASE, "agent");
        asm volatile("s_waitcnt vmcnt(0)" ::: "memory");
        __hip_atomic_fetch_add(p.E1DONE, 1u, __ATOMIC_RELAXED, __HIP_MEMORY_SCOPE_AGENT);
      }
      {
        int tn = tid;
        asm volatile("" : "+v"(tn));
        phaseNA(p, smem, tn, 64, gridDim.x - 64);
      }
    }
  }
  if constexpr (PH == 5) phaseF(p, tid);
  if constexpr (PH == 6) phaseG(p, (__half*)smem, tid);
  if constexpr (PH == 7) phaseH(p, tid);
}

__global__ void __launch_bounds__(NT, 2) mega(KArgs a) {
  extern __shared__ __attribute__((aligned(16))) float smem[];
  cg::grid_group grid = cg::this_grid();
  const int wave_s = __builtin_amdgcn_readfirstlane((int)(hipThreadIdx_x >> 6));
#ifdef TPROBE
#define TSTAMP(k) ts##k = wall_clock64()
  unsigned long long ts0 = 0, ts1 = 0, ts2 = 0, ts3 = 0, ts4 = 0, ts5 = 0, ts6 = 0, ts7 = 0, ts8 = 0;
#else
#define TSTAMP(k)
#endif
  unsigned* const bar = (unsigned*)(a.ws + OFF_BAR);
  volatile XB_LAS unsigned* const xst = (volatile XB_LAS unsigned*)((XB_LAS char*)smem + (LDS_BYTES - 16));
  if (blockIdx.x == 0)
    for (int i = threadIdx.x; i < XCD_BAR_WORDS; i += NT) __hip_atomic_store(bar + i, 0u, __ATOMIC_RELAXED, __HIP_MEMORY_SCOPE_AGENT);
  if (threadIdx.x == 0) {
    xst[0] = 0u;
    xst[1] = 0u;
  }
  TSTAMP(0);
  run_phase<0>(a, smem, wave_s); grid.sync(); TSTAMP(1);
  const XcdBarrier xb = xcd_barrier_post(bar, xst);
  run_phase<1>(a, smem, wave_s); xcd_barrier(xb); TSTAMP(2);
  run_phase<2>(a, smem, wave_s); xcd_barrier(xb); TSTAMP(3);
  run_phase<3>(a, smem, wave_s); xcd_barrier(xb); TSTAMP(4);
  run_phase<4>(a, smem, wave_s); xcd_barrier(xb); TSTAMP(5);
  run_phase<8>(a, smem, wave_s); xcd_barrier(xb); TSTAMP(6);
  run_phase<5>(a, smem, wave_s); xcd_barrier(xb); TSTAMP(7);
  run_phase<6>(a, smem, wave_s); xcd_barrier(xb); TSTAMP(8);
  run_phase<7>(a, smem, wave_s);
#ifdef TPROBE
  __syncthreads();
  if (blockIdx.x == 0) {
    int cnt = (int)((TPROBE_HI - TPROBE_LO) / 100);
    cnt = cnt > 1000 ? 1000 : cnt;
    for (int i = threadIdx.x; i < cnt; i += NT) a.out[i] += 0.1f;
  }
#endif
}

extern "C" void kernel_launch(void* const* d_in, const int* in_sizes, int n_in, void* d_out, int out_size, void* d_ws,
                              size_t ws_size, hipStream_t stream) {
  KArgs a{};
  for (int i = 0; i < 15; ++i) a.in[i] = (const float*)d_in[i];
  a.out = (float*)d_out;
  a.ws = (char*)d_ws;
  static int grid_blocks = 0;
  if (!grid_blocks) {
    int dev = 0, cus = 0, per_cu = 0;
    (void)hipGetDevice(&dev);
    (void)hipDeviceGetAttribute(&cus, hipDeviceAttributeMultiprocessorCount, dev);
    (void)hipFuncSetAttribute((const void*)mega, hipFuncAttributeMaxDynamicSharedMemorySize, LDS_BYTES);
    (void)hipOccupancyMaxActiveBlocksPerMultiprocessor(&per_cu, mega, NT, LDS_BYTES);
    if (per_cu < 1) per_cu = 1;
    grid_blocks = cus * per_cu;
  }
  void* args[] = {&a};
  hipError_t e = hipLaunchCooperativeKernel((void*)mega, dim3(grid_blocks), dim3(NT), args, LDS_BYTES, stream);
  if (e != hipSuccess) fprintf(stderr, "cooperative launch failed: %s (grid %d)\n", hipGetErrorString(e), grid_blocks);
}

#ifdef DIAG_PHASES
template <int PH>
__global__ void __launch_bounds__(NT, 2) phase_k(KArgs a) {
  extern __shared__ __attribute__((aligned(16))) float smem[];
  run_phase<PH>(a, smem, (int)(hipThreadIdx_x >> 6));
}
template __global__ void phase_k<2>(KArgs);
template __global__ void phase_k<3>(KArgs);
template __global__ void phase_k<4>(KArgs);
template __global__ void phase_k<8>(KArgs);
template __global__ void phase_k<6>(KArgs);
#endif
```

```cpp
#include <hip/hip_runtime.h>
#include <hip/hip_fp16.h>
#include <hip/hip_cooperative_groups.h>
#include <cstdio>
namespace cg = cooperative_groups;

#ifndef MK_MULTI
#define MK_MULTI 0
#endif

constexpr int L = 16384, CTX = 256, LT = L + CTX, D = 1024, IN_DIM = 4112;
constexpr int NT = 512, NWV = NT / 64;
constexpr int NPAD = 4352;
constexpr int LDS_BYTES = 147456;
typedef _Float16 f16x8 __attribute__((ext_vector_type(8)));
typedef _Float16 f16x4 __attribute__((ext_vector_type(4)));
typedef __fp16 h16x4 __attribute__((__vector_size__(4 * sizeof(__fp16))));
typedef float f32x4 __attribute__((ext_vector_type(4)));
constexpr int GW = 64;
constexpr float EPS = 1e-6f;

struct Params {
  const float *x, *c, *ctx, *c_ctx, *w_ada, *b_ada, *g_pre, *g_post, *w_in, *conv_w, *rpb, *A_log, *dt_bias,
      *gdn_norm_w, *w_out;
  float* out;
  float* mod;
  __half* WtI;
  __half* WtO;
  __half* H;
  __half* NAP;
  __half* VT;
  __half* GQ;
  __half* GZ;
  float* GBA;
  __half* QKV;
  float* BETA;
  float* GG;
  __half* TB;
  __half* QKM;
  float* SC;
  unsigned* E1DONE;
  float* ROPE;
  __half* OF;
  __half* OB;
  __half* MIX;
  __half* Y;
};

__device__ inline float wsum(float v) {
#pragma unroll
  for (int o = 32; o > 0; o >>= 1) v += __shfl_xor(v, o, 64);
  return v;
}
__device__ inline float wmax(float v) {
#pragma unroll
  for (int o = 32; o > 0; o >>= 1) v = fmaxf(v, __shfl_xor(v, o, 64));
  return v;
}
__device__ inline void store_h4(__half* dst, f32x4 v) {
  __half2 h[2] = {__floats2half2_rn(v[0], v[1]), __floats2half2_rn(v[2], v[3])};
  *(uint2*)dst = *(uint2*)h;
}

__device__ inline float siluf(float x) { return x * __builtin_amdgcn_rcpf(1.f + __expf(-x)); }

__device__ void transpose_tiles(const float* W, int ld, int Nvalid, int Npad, __half* Wt, float* smem, int tid, int b0,
                                int nb) {
  const int tn = Npad / 64, ntile = 16 * tn;
  const int kk0 = tid >> 4, n4 = (tid & 15) * 4;
  auto fetch = [&](int tile, float4& v0, float4& v1) {
    const int tk = tile / tn, tc = tile % tn;
    const int col = tc * 64 + n4;
    const float* src = W + (size_t)(tk * 64 + kk0) * ld + col;
    const bool ok = (tile < ntile) && (col < Nvalid);
    v0 = ok ? *(const float4*)src : make_float4(0.f, 0.f, 0.f, 0.f);
    v1 = ok ? *(const float4*)(src + (size_t)32 * ld) : make_float4(0.f, 0.f, 0.f, 0.f);
  };
  float4 c0, c1, x0, x1;
  int tile = (int)blockIdx.x - b0;
  fetch(tile, c0, c1);
  for (; tile < ntile; tile += nb) {
    fetch(tile + nb, x0, x1);
    const int tk = tile / tn, tc = tile % tn;
    __syncthreads();
    smem[kk0 * 65 + n4 + 0] = c0.x; smem[kk0 * 65 + n4 + 1] = c0.y; smem[kk0 * 65 + n4 + 2] = c0.z; smem[kk0 * 65 + n4 + 3] = c0.w;
    smem[(kk0 + 32) * 65 + n4 + 0] = c1.x; smem[(kk0 + 32) * 65 + n4 + 1] = c1.y;
    smem[(kk0 + 32) * 65 + n4 + 2] = c1.z; smem[(kk0 + 32) * 65 + n4 + 3] = c1.w;
    __syncthreads();
    {
      int nn = tid >> 3, k8 = (tid & 7) * 8;
      __half2 h[4];
#pragma unroll
      for (int i = 0; i < 4; ++i)
        h[i] = __floats2half2_rn(smem[(k8 + 2 * i) * 65 + nn], smem[(k8 + 2 * i + 1) * 65 + nn]);
      *(uint4*)(Wt + (size_t)(tc * 64 + nn) * 1024 + tk * 64 + k8) = *(uint4*)h;
    }
    c0 = x0;
    c1 = x1;
  }
}

__device__ void phaseA(const Params& p, float* smem, int tid) {
  int lane = tid & 63, w = tid >> 6;
  for (int item = blockIdx.x; item < 48; item += gridDim.x) {
    int j = item * 64 + lane;
    float a0 = 0.f, a1 = 0.f;
    int k0 = w * 128;
#pragma unroll 8
    for (int k = k0; k < k0 + 128; ++k) {
      float wv = p.w_ada[(size_t)k * 3072 + j];
      a0 += siluf(p.c[k]) * wv;
      a1 += siluf(p.c_ctx[k]) * wv;
    }
    __syncthreads();
    smem[(w * 2 + 0) * 64 + lane] = a0;
    smem[(w * 2 + 1) * 64 + lane] = a1;
    __syncthreads();
    if (w < 2) {
      float s = 0.f;
#pragma unroll
      for (int ww = 0; ww < NWV; ++ww) s += smem[(ww * 2 + w) * 64 + lane];
      p.mod[w * 3072 + j] = s + p.b_ada[j];
    }
    asm volatile("s_waitcnt vmcnt(0)" ::: "memory");
    __syncthreads();
    if (tid == 0) {
      __builtin_amdgcn_fence(__ATOMIC_RELEASE, "agent");
      asm volatile("s_waitcnt vmcnt(0)" ::: "memory");
      __hip_atomic_fetch_add(p.E1DONE + 2, 1u, __ATOMIC_RELAXED, __HIP_MEMORY_SCOPE_AGENT);
    }
  }
  for (int i = blockIdx.x * NT + tid; i < 320 * 32; i += gridDim.x * NT) {
    const int tr = i >> 5, fi = i & 31;
    const float posv = (float)((tr < 256) ? tr : tr - 256);
    const float ang = posv * powf(10000.f, -(float)(2 * fi) / 64.f);
    p.ROPE[2 * i] = cosf(ang);
    p.ROPE[2 * i + 1] = sinf(ang);
  }
  const int b0 = (gridDim.x > 96) ? 48 : 0, nb = gridDim.x - b0;
  if ((int)blockIdx.x >= b0) {
    transpose_tiles(p.w_in, IN_DIM, IN_DIM, NPAD, p.WtI, smem, tid, b0, nb);
    transpose_tiles(p.w_out, 1024, 1024, 1024, p.WtO, smem, tid, b0, nb);
  }
}

__device__ void phaseB(const Params& p, int tid) {
  int lane = tid & 63;
  int gw = blockIdx.x * NWV + (tid >> 6);
  int nw = gridDim.x * NWV;
  if (tid == 0) {
    unsigned spins = 0;
    while (__hip_atomic_load(p.E1DONE + 2, __ATOMIC_RELAXED, __HIP_MEMORY_SCOPE_AGENT) < 48u && ++spins < (1u << 24)) __builtin_amdgcn_s_sleep(2);
    __builtin_amdgcn_fence(__ATOMIC_ACQUIRE, "agent");
    asm volatile("s_waitcnt vmcnt(0)" ::: "memory");
  }
  __syncthreads();
  float4 fa[4], fb[4];
  auto factors = [&](const float* md) {
#pragma unroll
    for (int i = 0; i < 4; ++i) {
      const int j = i * 256 + lane * 4;
      const float4 g = *(const float4*)(p.g_pre + j), sh = *(const float4*)(md + j), sc = *(const float4*)(md + 1024 + j);
      fa[i] = make_float4(g.x * (1.f + sc.x), g.y * (1.f + sc.y), g.z * (1.f + sc.z), g.w * (1.f + sc.w));
      fb[i] = sh;
    }
  };
  factors(p.mod);
  bool ctx_f = false;
  for (int r0 = gw; r0 < LT; r0 += 2 * nw) {
    float4 v[2][4];
#pragma unroll
    for (int u = 0; u < 2; ++u) {
      const int r = min(r0 + u * nw, LT - 1);
      const float* src = (r < L) ? p.x + (size_t)r * D : p.ctx + (size_t)(r - L) * D;
#pragma unroll
      for (int i = 0; i < 4; ++i) v[u][i] = *(const float4*)(src + i * 256 + lane * 4);
    }
#pragma unroll
    for (int u = 0; u < 2; ++u) {
      const int r = r0 + u * nw;
      if (r >= LT) break;
      if (r >= L && !ctx_f) {
        factors(p.mod + 3072);
        ctx_f = true;
      }
      float ss = 0.f;
#pragma unroll
      for (int i = 0; i < 4; ++i) ss += v[u][i].x * v[u][i].x + v[u][i].y * v[u][i].y + v[u][i].z * v[u][i].z + v[u][i].w * v[u][i].w;
      ss = wsum(ss);
      const float inv = rsqrtf(ss * (1.f / D) + EPS);
#pragma unroll
      for (int i = 0; i < 4; ++i) {
        const int j = i * 256 + lane * 4;
        const float o0 = v[u][i].x * inv * fa[i].x + fb[i].x;
        const float o1 = v[u][i].y * inv * fa[i].y + fb[i].y;
        const float o2 = v[u][i].z * inv * fa[i].z + fb[i].z;
        const float o3 = v[u][i].w * inv * fa[i].w + fb[i].w;
        __half2 h[2] = {__floats2half2_rn(o0, o1), __floats2half2_rn(o2, o3)};
        *(uint2*)(p.H + (size_t)r * D + j) = *(uint2*)h;
      }
    }
  }
}

namespace g8 {
constexpr int BM = 256, BK = 64, HALF = 128, NXCD = 8, WGM = 8, HT = HALF * BK;
__device__ __forceinline__ int lds_byte(int r, int c) {
  int st = (r >> 4) * 2 + (c >> 5), rr = r & 15, cc = c & 31, ob = rr * 64 + cc * 2;
  return st * 1024 + (ob ^ (((ob >> 9) & 1) << 5));
}
__device__ __forceinline__ void stage_rc(int b, int& R, int& C) {
  int st = b / 1024, sb = b % 1024, swz = sb ^ (((sb >> 9) & 1) << 5);
  R = (st >> 1) * 16 + swz / 64;
  C = (st & 1) * 32 + (swz % 64) / 2;
}
}

template <int nM, int nN, int pn0, int ntiles, int pmx, int pnx, class Epi>
__device__ void gemm_mfma(const __half* __restrict__ A, const __half* __restrict__ Bt, __half* shm, int tid, int b0, int nb,
                          Epi epi) {
  using namespace g8;
  constexpr int KK = 1024;
  const int sb0 = tid * 16, sb1 = sb0 + 8192;
  int vo0, vo1;
  {
    int r0, c0, r1, c1;
    stage_rc(sb0, r0, c0);
    stage_rc(sb1, r1, c1);
    vo0 = r0 * KK + c0;
    vo1 = r1 * KK + c1;
  }
#define SA(b, h) (shm + ((b)*2 + (h)) * HT)
#define SB(b, h) (shm + (4 + (b)*2 + (h)) * HT)
#define STAGE(P, BASE, br, kt)                                                                             \
  do {                                                                                                     \
    const __half* _gb = (BASE) + (long)(br)*KK + (long)(kt)*BK;                                            \
    __builtin_amdgcn_global_load_lds((const unsigned*)(_gb + vo0),                                         \
                                     (__attribute__((address_space(3))) unsigned*)((char*)(P) + sb0), 16, 0, 0); \
    __builtin_amdgcn_global_load_lds((const unsigned*)(_gb + vo1),                                         \
                                     (__attribute__((address_space(3))) unsigned*)((char*)(P) + sb1), 16, 0, 0); \
  } while (0)
#define LDA(dst, b, h)                                                                                     \
  for (int m = 0; m < 4; ++m)                                                                              \
    for (int k = 0; k < 2; ++k)                                                                            \
  dst[m][k] = *reinterpret_cast<const f16x8*>((char*)SA(b, h) + lds_byte(wr * 64 + m * 16 + fr, k * 32 + fq * 8))
#define LDB(dst, b, h)                                                                                     \
  for (int n = 0; n < 2; ++n)                                                                              \
    for (int k = 0; k < 2; ++k)                                                                            \
  dst[n][k] = *reinterpret_cast<const f16x8*>((char*)SB(b, h) + lds_byte(wc * 32 + n * 16 + fr, k * 32 + fq * 8))
#define MMA(ai, bj, At_, Bt_)                                                                              \
  do {                                                                                                     \
    __builtin_amdgcn_s_setprio(1);                                                                         \
    for (int m = 0; m < 4; ++m)                                                                            \
      for (int n = 0; n < 2; ++n)                                                                          \
        for (int k = 0; k < 2; ++k)                                                                        \
          acc[ai][bj][m][n] =                                                                              \
              __builtin_amdgcn_mfma_f32_16x16x32_f16(Bt_[n][k], At_[m][k], acc[ai][bj][m][n], 0, 0, 0);  \
    __builtin_amdgcn_s_setprio(0);                                                                         \
  } while (0)
#define WAIT_V(n) asm volatile("s_waitcnt vmcnt(" #n ")" ::: "memory")
#define WAIT_L(n) asm volatile("s_waitcnt lgkmcnt(" #n ")" ::: "memory")
#define BAR __builtin_amdgcn_s_barrier()
#define SCHED __builtin_amdgcn_sched_barrier(0)
  constexpr int nwg = nM * nN;
  const int wid = tid >> 6, lane = tid & 63, wr = wid >> 2, wc = wid & 3, fr = lane & 15, fq = lane >> 4;
  constexpr int nt = KK / BK;
  for (int tile = (int)blockIdx.x - b0; tile < ntiles; tile += nb) {
    int pm, pn;
    if (tile < nwg) {
      int wgid = tile;
      {
        int q = nwg / NXCD, r = nwg % NXCD, xcd = wgid % NXCD, off = wgid / NXCD;
        wgid = (xcd < r ? xcd * (q + 1) : r * (q + 1) + (xcd - r) * q) + off;
      }
      int nig = WGM * nN, gid = wgid / nig, fm = gid * WGM, gsz = min(nM - fm, WGM);
      pm = fm + ((wgid % nig) % gsz);
      pn = pn0 + (wgid % nig) / gsz;
    } else {
      pm = pmx + (tile - nwg);
      pn = pnx;
    }
    const int brow = pm * BM, bcol = pn * BM;
    f32x4 acc[2][2][4][2] = {};
    f16x8 At[4][2], B0[2][2], B1[2][2];
    STAGE(SB(0, 0), Bt, bcol, 0);
    STAGE(SA(0, 0), A, brow, 0);
    STAGE(SB(0, 1), Bt, bcol + HALF, 0);
    STAGE(SA(0, 1), A, brow + HALF, 0);
    if (wr == 1) BAR;
    WAIT_V(4);
    BAR;
    STAGE(SB(1, 0), Bt, bcol, 1);
    STAGE(SA(1, 0), A, brow, 1);
    STAGE(SB(1, 1), Bt, bcol + HALF, 1);
    WAIT_V(6);
    BAR;
    for (int t = 0; t < nt - 2; t += 2) {
      LDB(B0, 0, 0); SCHED; LDA(At, 0, 0); STAGE(SA(1, 1), A, brow + HALF, t + 1);
      WAIT_L(8); BAR; WAIT_L(0); MMA(0, 0, At, B0); BAR; SCHED;
      LDB(B1, 0, 1); STAGE(SB(0, 0), Bt, bcol, t + 2);
      BAR; WAIT_L(0); MMA(0, 1, At, B1); BAR;
      LDA(At, 0, 1); STAGE(SA(0, 0), A, brow, t + 2);
      BAR; WAIT_L(0); MMA(1, 0, At, B0); BAR; SCHED;
      STAGE(SB(0, 1), Bt, bcol + HALF, t + 2);
      WAIT_V(6); BAR; MMA(1, 1, At, B1); BAR;
      LDB(B0, 1, 0); SCHED; LDA(At, 1, 0); STAGE(SA(0, 1), A, brow + HALF, t + 2);
      WAIT_L(8); BAR; WAIT_L(0); MMA(0, 0, At, B0); BAR; SCHED;
      LDB(B1, 1, 1); STAGE(SB(1, 0), Bt, bcol, t + 3);
      BAR; WAIT_L(0); MMA(0, 1, At, B1); BAR;
      LDA(At, 1, 1); STAGE(SA(1, 0), A, brow, t + 3);
      BAR; WAIT_L(0); MMA(1, 0, At, B0); BAR; SCHED;
      STAGE(SB(1, 1), Bt, bcol + HALF, t + 3);
      WAIT_V(6); BAR; MMA(1, 1, At, B1); BAR;
    }
    {
      LDB(B0, 0, 0); LDA(At, 0, 0); STAGE(SA(1, 1), A, brow + HALF, nt - 1);
      BAR; WAIT_L(0); MMA(0, 0, At, B0); BAR;
      LDB(B1, 0, 1); BAR; WAIT_L(0); MMA(0, 1, At, B1); BAR;
      LDA(At, 0, 1); WAIT_V(4); BAR; WAIT_L(0); MMA(1, 0, At, B0); MMA(1, 1, At, B1); BAR;
    }
    {
      LDB(B0, 1, 0); LDA(At, 1, 0); WAIT_V(2); BAR; WAIT_L(0); MMA(0, 0, At, B0); BAR;
      LDB(B1, 1, 1); WAIT_V(0); BAR; WAIT_L(0); MMA(0, 1, At, B1); BAR;
      LDA(At, 1, 1); BAR; WAIT_L(0); MMA(1, 0, At, B0); MMA(1, 1, At, B1); BAR;
    }
    if (wr == 0) BAR;
    {
      int t2 = tid;
      asm volatile("" : "+v"(t2));
      const int ewid = t2 >> 6, el = t2 & 63, ewr = ewid >> 2, ewc = ewid & 3, efr = el & 15, efq = el >> 4;
      epi(brow, bcol, acc, ewr * 64 + efr, ewc * 32 + efq * 4);
    }
  }
#undef SA
#undef SB
#undef STAGE
#undef LDA
#undef LDB
#undef MMA
}

__device__ void phaseC(const Params& p, __half* shm, int tid, bool first, int b0, int nb) {
  auto epi = [&](int brow, int bcol, const f32x4(&acc)[2][2][4][2], int r0, int c0) {
    if (bcol >= 1024 && bcol < 1536) {
#pragma unroll
      for (int ai = 0; ai < 2; ++ai)
#pragma unroll
        for (int bj = 0; bj < 2; ++bj)
#pragma unroll
          for (int m = 0; m < 4; ++m)
#pragma unroll
            for (int n = 0; n < 2; ++n) {
              __half* vt = p.VT + (size_t)(bcol - 1024 + bj * 128 + n * 16 + c0) * LT + (brow + ai * 128 + m * 16 + r0);
              const f32x4 v = acc[ai][bj][m][n];
              vt[0] = __float2half(v[0]);
              vt[LT] = __float2half(v[1]);
              vt[2 * LT] = __float2half(v[2]);
              vt[3 * LT] = __float2half(v[3]);
            }
    } else if (bcol >= 4096) {
      if (c0 < 16) {
#pragma unroll
        for (int ai = 0; ai < 2; ++ai)
#pragma unroll
          for (int m = 0; m < 4; ++m)
            *(f32x4*)(p.GBA + (size_t)(brow + ai * 128 + m * 16 + r0) * 16 + c0) = acc[ai][0][m][0];
      }
    } else {
      __half* base;
      int ld;
      if (bcol < 1024) {
        base = p.NAP + bcol; ld = 1536;
      } else if (bcol < 2048) {
        base = p.NAP + (bcol - 512); ld = 1536;
      } else if (bcol < 3584) {
        base = p.GQ + (bcol - 2048); ld = 1536;
      } else {
        base = p.GZ + (bcol - 3584); ld = 512;
      }
#pragma unroll
      for (int ai = 0; ai < 2; ++ai)
#pragma unroll
        for (int m = 0; m < 4; ++m) {
          __half* rowp = base + (size_t)(brow + ai * 128 + m * 16 + r0) * ld + c0;
#pragma unroll
          for (int bj = 0; bj < 2; ++bj)
#pragma unroll
            for (int n = 0; n < 2; ++n) store_h4(rowp + bj * 128 + n * 16, acc[ai][bj][m][n]);
        }
    }
  };
  if (first) {
    gemm_mfma<65, 15, 2, 1024, 16, 1>(p.H, p.WtI, shm, tid, b0, nb, epi);
  } else {
    gemm_mfma<65, 1, 0, 81, 0, 1>(p.H, p.WtI, shm, tid, b0, nb, epi);
  }
}

__device__ void phaseD_gdnpre(const Params& p, int tid) {
  const int lane = tid & 63;
  const int gw = blockIdx.x * NWV + (tid >> 6);
  const int nw3 = (gridDim.x * NWV) / 3;
  const int third = gw % 3, slot = gw / 3;
  if (slot >= nw3) return;
  const int c16 = lane & 15;
  const int axis = c16 >> 3, hq = c16 & 3;
  const bool first = (c16 & 4) == 0;
  const int ch = third * 512 + lane * 8;
  float wv[5][8];
#pragma unroll
  for (int j = 0; j < 5; ++j) {
    const f32x4 w0 = *(const f32x4*)(p.conv_w + j * 1536 + ch), w1 = *(const f32x4*)(p.conv_w + j * 1536 + ch + 4);
#pragma unroll
    for (int e = 0; e < 4; ++e) {
      wv[j][e] = w0[e];
      wv[j][4 + e] = w1[e];
    }
  }
  const float dtb = (lane < 8) ? p.dt_bias[lane] : 0.f, aexp = (lane < 8) ? -expf(p.A_log[lane]) : 0.f;
  for (int r0 = slot; r0 < LT; r0 += 2 * nw3) {
    f16x8 xv[2][5];
    float msk[2][5];
    f32x4 cs4[2][4];
    float gb[2], ga[2];
#pragma unroll
    for (int u = 0; u < 2; ++u) {
      const int r = min(r0 + u * nw3, LT - 1);
      const int pos = (r < L) ? r : r - L, len = (r < L) ? L : CTX, base = (r < L) ? 0 : L;
#pragma unroll
      for (int j = 0; j < 5; ++j) {
        const int pp = pos + j - 2;
        const bool ok = (pp >= 0 && pp < len);
        msk[u][j] = ok ? 1.f : 0.f;
        const f16x8 xl = *(const f16x8*)(p.GQ + (size_t)(base + min(max(pp, 0), len - 1)) * 1536 + ch);
        xv[u][j] = ok ? xl : (f16x8){};
      }
      const int tr = (axis == 0) ? (pos / GW) : (256 + pos % GW);
      const f32x4* csp = (const f32x4*)(p.ROPE + (size_t)(tr * 32 + hq * 8) * 2);
#pragma unroll
      for (int e = 0; e < 4; ++e) cs4[u][e] = csp[e];
      gb[u] = (lane < 8) ? p.GBA[(size_t)r * 16 + lane] : 0.f;
      ga[u] = (lane < 8) ? p.GBA[(size_t)r * 16 + 8 + lane] : 0.f;
    }
#pragma unroll
    for (int u = 0; u < 2; ++u) {
      const int r = r0 + u * nw3;
      if (r >= LT) break;
      float a[8];
#pragma unroll
      for (int e = 0; e < 8; ++e) a[e] = 0.f;
#pragma unroll
      for (int j = 0; j < 5; ++j)
#pragma unroll
        for (int e = 0; e < 8; ++e) a[e] += wv[j][e] * (float)xv[u][j][e];
#pragma unroll
      for (int e = 0; e < 8; ++e) a[e] = siluf(a[e]);
      if (third < 2) {
        float ss = 0.f;
#pragma unroll
        for (int e = 0; e < 8; ++e) ss += a[e] * a[e];
        ss += __shfl_xor(ss, 1, 64);
        ss += __shfl_xor(ss, 2, 64);
        ss += __shfl_xor(ss, 4, 64);
        ss += __shfl_xor(ss, 8, 64);
        const float inv = rsqrtf(ss + EPS);
#pragma unroll
        for (int e = 0; e < 8; ++e) a[e] *= inv;
        if (r < L) {
#pragma unroll
          for (int e = 0; e < 8; ++e) {
            const float other = __shfl_xor(a[e], 4, 64);
            const float cc = cs4[u][e >> 1][(e & 1) * 2], sn = cs4[u][e >> 1][(e & 1) * 2 + 1];
            a[e] = first ? (a[e] * cc - other * sn) : (a[e] * cc + other * sn);
          }
        }
      }
      {
        __half2 h[4];
#pragma unroll
        for (int e = 0; e < 4; ++e) h[e] = __floats2half2_rn(a[2 * e], a[2 * e + 1]);
        *(uint4*)(p.QKV + (size_t)r * 1536 + ch) = *(uint4*)h;
      }
      if (third == 0 && lane < 8) {
        const float beta = __builtin_amdgcn_rcpf(1.f + __expf(-gb[u]));
        const float xx = ga[u] + dtb;
        const float sp = (xx > 20.f) ? xx : log1pf(expf(xx));
        p.BETA[(size_t)r * 8 + lane] = beta;
        p.GG[(size_t)r * 8 + lane] = aexp * sp;
      }
    }
  }
}

#define MFMA16(a, b, c) __builtin_amdgcn_mfma_f32_16x16x32_f16(a, b, c, 0, 0, 0)
__device__ void phaseNA(const Params& p, float* smem, int tid, int b0, int nb) {
  const int lane = tid & 63, w = tid >> 6, fr = lane & 15, fq = lane >> 4;
  const int t = w & 3, g = w >> 2;
  float* rp = smem;
  float* xch = smem + 512;
  int hcur = -1;
  for (int item = (int)blockIdx.x - b0; item < 2048; item += nb) {
    const int r = item >> 3, h = item & 7;
    if (h != hcur) {
      __syncthreads();
      for (int i = tid; i < 465; i += NT) rp[i] = p.rpb[h * 465 + i];
      hcur = h;
      __syncthreads();
    }
    const int rs = min(max(r - 4, 0), 248);
    const int ws = (t == 0) ? 0 : (t == 1) ? 8 : (t == 2) ? 24 : 32;
    const int c = 16 * t + fr;
    const int cs = min(max(c - 8, 0), 48);
    const int tq = r * 64 + c;
    f16x8 qf[2];
    qf[0] = *(const f16x8*)(p.NAP + (size_t)tq * 1536 + h * 64 + 8 * fq);
    qf[1] = *(const f16x8*)(p.NAP + (size_t)tq * 1536 + h * 64 + 32 + 8 * fq);
    f32x4 s[16];
    {
      f16x8 kb[32];
#pragma unroll
      for (int nt = 0; nt < 16; ++nt) {
        const int tb = (g == 0) ? (rs + (nt >> 1)) * 64 + ws : L + 32 * (nt >> 1);
        const int tokr = tb + 8 * (fr >> 2) + 4 * (nt & 1) + (fr & 3);
        const __half* kp = p.NAP + (size_t)tokr * 1536 + 512 + h * 64 + 8 * fq;
        kb[2 * nt] = *(const f16x8*)kp;
        kb[2 * nt + 1] = *(const f16x8*)(kp + 32);
      }
#pragma unroll
      for (int nt = 0; nt < 16; ++nt) {
        f32x4 acc = {0.f, 0.f, 0.f, 0.f};
        acc = MFMA16(kb[2 * nt], qf[0], acc);
        acc = MFMA16(kb[2 * nt + 1], qf[1], acc);
        s[nt] = acc;
      }
    }
    f16x8 vb[32];
#pragma unroll
    for (int ks = 0; ks < 8; ++ks) {
      const int tokA = ((g == 0) ? (rs + ks) * 64 + ws : L + 32 * ks) + 8 * fq;
#pragma unroll
      for (int nd = 0; nd < 4; ++nd) vb[4 * ks + nd] = *(const f16x8*)(p.VT + (size_t)(h * 64 + 16 * nd + fr) * LT + tokA);
    }
    float m = -1e30f;
#pragma unroll
    for (int nt = 0; nt < 16; ++nt)
#pragma unroll
      for (int rr = 0; rr < 4; ++rr) {
        float v = s[nt][rr] * 0.125f;
        if (g == 0) {
          const int i = nt >> 1, kc = ws + 8 * fq + 4 * (nt & 1) + rr;
          const bool ok = (kc >= cs) && (kc < cs + 16);
          const float bias = rp[(rs + i - r + 7) * 31 + min(max(kc - c + 15, 0), 30)];
          v = ok ? v + bias : -1e30f;
        }
        s[nt][rr] = v;
        m = fmaxf(m, v);
      }
    m = fmaxf(m, __shfl_xor(m, 16, 64));
    m = fmaxf(m, __shfl_xor(m, 32, 64));
    float l = 0.f;
#pragma unroll
    for (int nt = 0; nt < 16; ++nt)
#pragma unroll
      for (int rr = 0; rr < 4; ++rr) {
        const float e = __expf(s[nt][rr] - m);
        s[nt][rr] = e;
        l += e;
      }
    l += __shfl_xor(l, 16, 64);
    l += __shfl_xor(l, 32, 64);
    f32x4 o[4];
#pragma unroll
    for (int nd = 0; nd < 4; ++nd) o[nd] = (f32x4){0.f, 0.f, 0.f, 0.f};
#pragma unroll
    for (int ks = 0; ks < 8; ++ks) {
      f16x8 pf;
#pragma unroll
      for (int j = 0; j < 4; ++j) {
        pf[j] = (_Float16)s[2 * ks][j];
        pf[4 + j] = (_Float16)s[2 * ks + 1][j];
      }
#pragma unroll
      for (int nd = 0; nd < 4; ++nd) {
        o[nd] = MFMA16(vb[4 * ks + nd], pf, o[nd]);
      }
    }
    float* xc = xch + (t * 64 + lane) * 18;
    if (g == 1) {
      xc[0] = m;
      xc[1] = l;
#pragma unroll
      for (int nd = 0; nd < 4; ++nd)
#pragma unroll
        for (int rr = 0; rr < 4; ++rr) xc[2 + nd * 4 + rr] = o[nd][rr];
    }
    __syncthreads();
    if (g == 0) {
      const float m1 = xc[0], l1 = xc[1];
      const float mm = fmaxf(m, m1);
      const float a0 = __expf(m - mm), a1 = __expf(m1 - mm);
      const float inv = 1.f / (l * a0 + l1 * a1);
#pragma unroll
      for (int nd = 0; nd < 4; ++nd) {
        const f16x4 z = *(const f16x4*)(p.NAP + (size_t)tq * 1536 + 1024 + h * 64 + 16 * nd + 4 * fq);
        f32x4 ov;
#pragma unroll
        for (int rr = 0; rr < 4; ++rr) ov[rr] = (o[nd][rr] * a0 + xc[2 + nd * 4 + rr] * a1) * inv * siluf((float)z[rr]);
        store_h4(p.MIX + (size_t)tq * 1024 + h * 64 + 16 * nd + 4 * fq, ov);
      }
    }
    __syncthreads();
  }
}

__device__ inline int seqrow(int dir, int n) {
  if (dir == 0) return (n < CTX) ? (L + n) : (n - CTX);
  return (n < CTX) ? (L + CTX - 1 - n) : (L - 1 - (n - CTX));
}
constexpr int NCH = LT / 64;
constexpr int E1_SPLIT = 71;

__device__ void phaseE1(const Params& p, float* smem, int tid, int b0, int nb, int idx_lo, int idx_hi) {
  const int lane = tid & 63, w = tid >> 6, fr = lane & 15, fq = lane >> 4;
  float* Am = smem + w * (64 * 68);
  float* gs = smem + 8 * (64 * 68) + w * 128;
  const float scale = 0.08838834764831845f;
  for (int idx = idx_lo + ((int)blockIdx.x - b0) + w * nb; idx < idx_hi; idx += nb * NWV) {
    const int chain = idx & 7, n = idx >> 3;
    const int item = chain * NCH + n;
    const int dir = chain >> 2, hd = chain & 3;
    const int row_s = seqrow(dir, n * 64 + lane);
    const float g = p.GG[(size_t)row_s * 8 + dir * 4 + hd], beta = p.BETA[(size_t)row_s * 8 + dir * 4 + hd];
    float gc = g;
#pragma unroll
    for (int o = 1; o < 64; o <<= 1) {
      float t = __shfl_up(gc, o, 64);
      if (lane >= o) gc += t;
    }
    const float gl = __shfl(gc, 63, 64);
    {
      const float e = __expf(gc);
      float* sc = p.SC + (size_t)item * 320;
      sc[lane] = beta * e;
      sc[64 + lane] = __expf(gl - gc);
      sc[128 + lane] = scale * e;
      sc[192 + lane] = beta;
      if (lane == 0) sc[256] = __expf(gl);
    }
    gs[lane] = gc;
    gs[64 + lane] = beta;
    f16x8 kf[4][4];
    auto loadk = [&]() {
#pragma unroll
      for (int m = 0; m < 4; ++m) {
        const int row = seqrow(dir, n * 64 + 16 * m + fr);
        const __half* base = p.QKV + (size_t)row * 1536 + 512 + hd * 128 + 8 * fq;
#pragma unroll
        for (int kk = 0; kk < 4; ++kk) kf[m][kk] = *(const f16x8*)(base + 32 * kk);
      }
    };
    loadk();
    __builtin_amdgcn_wave_barrier();
#pragma unroll
    for (int mi = 0; mi < 4; ++mi) {
      const f32x4 gci = *(const f32x4*)(gs + 16 * mi + 4 * fq);
      const f32x4 bti = *(const f32x4*)(gs + 64 + 16 * mi + 4 * fq);
#pragma unroll
      for (int nj = 0; nj <= mi; ++nj) {
        f32x4 acc = {0.f, 0.f, 0.f, 0.f};
#pragma unroll
        for (int kk = 0; kk < 4; ++kk) acc = MFMA16(kf[mi][kk], kf[nj][kk], acc);
        const int j = 16 * nj + fr;
        const float gcj = gs[j];
#pragma unroll
        for (int r = 0; r < 4; ++r) {
          const int i = 16 * mi + 4 * fq + r;
          float val = bti[r] * acc[r] * __expf(fminf(gci[r] - gcj, 0.f));
          Am[i * 68 + j] = (i > j) ? val : 0.f;
        }
      }
    }
    __builtin_amdgcn_wave_barrier();
    {
      int lane_i = lane;
      asm volatile("" : "+v"(lane_i));
      float Ar[64], Tr[64];
#pragma unroll
      for (int j4 = 0; j4 < 16; ++j4) {
        const f32x4 av = *(const f32x4*)(Am + lane_i * 68 + 4 * j4);
#pragma unroll
        for (int e = 0; e < 4; ++e) Ar[4 * j4 + e] = (4 * j4 + e < lane_i) ? av[e] : 0.f;
      }
#pragma unroll
      for (int c = 0; c < 64; ++c) Tr[c] = (c == lane_i) ? 1.f : 0.f;
#pragma unroll
      for (int j = 0; j < 63; ++j) {
#pragma unroll
        for (int c = 0; c <= j; ++c) {
          const float tjc = __builtin_bit_cast(float, __builtin_amdgcn_readlane(__builtin_bit_cast(int, Tr[c]), j));
          Tr[c] -= Ar[j] * tjc;
        }
      }
      __half* Tb = p.TB + (size_t)item * 4096 + lane_i * 64;
#pragma unroll
      for (int c8 = 0; c8 < 8; ++c8) {
        __half2 h[4];
#pragma unroll
        for (int e = 0; e < 4; ++e) h[e] = __floats2half2_rn(Tr[8 * c8 + 2 * e], Tr[8 * c8 + 2 * e + 1]);
        *(uint4*)(Tb + 8 * c8) = *(uint4*)h;
      }
    }
    asm volatile("" ::: "memory");
    loadk();
    __half* Qb = p.QKM + (size_t)item * 4096;
#pragma unroll
    for (int mi = 0; mi < 4; ++mi) {
      f16x8 qf[4];
      {
        const int row = seqrow(dir, n * 64 + 16 * mi + fr);
        const __half* base = p.QKV + (size_t)row * 1536 + hd * 128 + 8 * fq;
#pragma unroll
        for (int kk = 0; kk < 4; ++kk) qf[kk] = *(const f16x8*)(base + 32 * kk);
      }
      const int i = 16 * mi + fr;
      const float gci = gs[i];
#pragma unroll
      for (int nj = 0; nj < 4; ++nj) {
        f32x4 acc = {0.f, 0.f, 0.f, 0.f};
        if (nj <= mi) {
#pragma unroll
          for (int kk = 0; kk < 4; ++kk) acc = MFMA16(kf[nj][kk], qf[kk], acc);
          const f32x4 gcj = *(const f32x4*)(gs + 16 * nj + 4 * fq);
#pragma unroll
          for (int r = 0; r < 4; ++r) {
            const int j = 16 * nj + 4 * fq + r;
            float val = acc[r] * scale * __expf(fminf(gci - gcj[r], 0.f));
            acc[r] = (i >= j) ? val : 0.f;
          }
        }
        store_h4(Qb + i * 64 + 16 * nj + 4 * fq, acc);
      }
    }
    __builtin_amdgcn_wave_barrier();
  }
}

__device__ void phaseE2(const Params& p, float* smem, int tid) {
  const int chain = blockIdx.x & 7, slice = blockIdx.x >> 3, dir = chain >> 2, hd = chain & 3, e0 = slice * 16;
  const int lane = tid & 63, w = __builtin_amdgcn_readfirstlane(tid >> 6), fr = lane & 15, fq = lane >> 4;
  char* lds = (char*)smem;
  constexpr int SLOT = 56576, O_K = 0, O_Q = 17408, O_T = 34816, O_QK = 44032, O_V = 53248, O_SC = 55296;
  constexpr int O_ST = 2 * SLOT;
  constexpr int O_VN = O_ST + 3 * 4352;
  constexpr int O_RHS = O_VN + 2 * 2304;
  constexpr int O_VND = O_RHS + 2304;
  constexpr int O_DMY = O_VND + 2304;
  static_assert(O_DMY + 512 * 16 <= LDS_BYTES, "scan LDS map");
  __half* Od = dir ? p.OB : p.OF;
  auto relrow = [&](int pos) { return dir ? 63 - pos : pos; };
  auto rowbase = [&](int m) { return dir == 0 ? (m < 4 ? L + 64 * m : 64 * (m - 4)) : (m < 4 ? L + 192 - 64 * m : L - 64 * (m - 3)); };

  for (int i = tid; i < 16 * 136; i += NT) ((__half*)(lds + O_ST))[i] = __float2half(0.f);

  if (w >= 2) {
    unsigned goff0 = 0, loff0 = 0, goff1 = 0, loff1 = 0, goff2 = 0, loff2 = 0, goff3 = 0, loff3 = 0, goff4 = 0, loff4 = 0, goff5 = 0, loff5 = 0, goff6 = 0, loff6 = 0, goff7 = 0, loff7 = 0, goff8 = 0, loff8 = 0, goff9 = 0, loff9 = 0, goff10 = 0, loff10 = 0, goff11 = 0, loff11 = 0;
    auto piece = [&](int j, unsigned& g, unsigned& l) {
      g = 0;
      l = O_DMY + tid * 16;
      if (w <= 5 && j < 8) {
        const int f = ((tid - 128) & 127) + 128 * j, pos = f >> 4, c16 = f & 15;
        g = relrow(pos) * 3072u + ((w <= 3 ? 512 : 0) + hd * 128 + c16 * 8) * 2u;
        l = (w <= 3 ? O_K : O_Q) + pos * 272 + c16 * 16;
      } else if (w >= 6 && j < 8) {
        const int f = lane + 64 * j;
        if (!((f >> 3) < 32 && (f & 7) >= 4)) {
          g = f * 16u;
          l = (w == 6 ? O_T : O_QK) + (f >> 3) * 144 + (f & 7) * 16;
        }
      } else if (w == 7 && j < 10) {
        const int f = lane + 64 * (j - 8);
        g = relrow(f >> 1) * 3072u + (1024 + hd * 128 + e0 + (f & 1) * 8) * 2u;
        l = O_V + (f >> 1) * 32 + (f & 1) * 16;
      } else if (w == 7) {
        const int f = lane + 64 * (j - 10);
        if (f < 80) {
          g = f * 16u;
          l = O_SC + f * 16;
        }
      }
    };
    piece(0, goff0, loff0);
    piece(1, goff1, loff1);
    piece(2, goff2, loff2);
    piece(3, goff3, loff3);
    piece(4, goff4, loff4);
    piece(5, goff5, loff5);
    piece(6, goff6, loff6);
    piece(7, goff7, loff7);
    piece(8, goff8, loff8);
    piece(9, goff9, loff9);
    piece(10, goff10, loff10);
    piece(11, goff11, loff11);
    uint4 R0_0 = {}, R0_1 = {}, R0_2 = {}, R0_3 = {}, R0_4 = {}, R0_5 = {}, R0_6 = {}, R0_7 = {}, R0_8 = {}, R0_9 = {}, R0_10 = {}, R0_11 = {}, R1_0 = {}, R1_1 = {}, R1_2 = {}, R1_3 = {}, R1_4 = {}, R1_5 = {}, R1_6 = {}, R1_7 = {}, R1_8 = {}, R1_9 = {}, R1_10 = {}, R1_11 = {}, R2_0 = {}, R2_1 = {}, R2_2 = {}, R2_3 = {}, R2_4 = {}, R2_5 = {}, R2_6 = {}, R2_7 = {}, R2_8 = {}, R2_9 = {}, R2_10 = {}, R2_11 = {};
#define LD_ISSUE(S, mm)                                                                                   \
  do {                                                                                                    \
    const int m_ = min((mm), NCH - 1);                                                                    \
    const size_t item_ = (size_t)chain * NCH + m_;                                                        \
    const char* b0_ = (const char*)(p.QKV + (size_t)rowbase(m_) * 1536);                                  \
    const char* bA_ = (w <= 5) ? b0_ : (w == 6 ? (const char*)(p.TB + item_ * 4096) : (const char*)(p.QKM + item_ * 4096)); \
    const char* bS_ = (w == 7) ? (const char*)(p.SC + item_ * 320) : b0_;                                 \
    R##S##_0 = *(const uint4*)(bA_ + goff0);                                                         \
    R##S##_1 = *(const uint4*)(bA_ + goff1);                                                         \
    R##S##_2 = *(const uint4*)(bA_ + goff2);                                                         \
    R##S##_3 = *(const uint4*)(bA_ + goff3);                                                         \
    R##S##_4 = *(const uint4*)(bA_ + goff4);                                                         \
    R##S##_5 = *(const uint4*)(bA_ + goff5);                                                         \
    R##S##_6 = *(const uint4*)(bA_ + goff6);                                                         \
    R##S##_7 = *(const uint4*)(bA_ + goff7);                                                         \
    R##S##_8 = *(const uint4*)(b0_ + goff8);                                                         \
    R##S##_9 = *(const uint4*)(b0_ + goff9);                                                         \
    R##S##_10 = *(const uint4*)(bS_ + goff10);                                                         \
    R##S##_11 = *(const uint4*)(bS_ + goff11);                                                         \
  } while (0)
#define LD_WRITE(S, mm)                                                                                   \
  do {                                                                                                    \
    char* sl_ = lds + ((mm)&1) * SLOT;                                                                    \
    *(uint4*)((loff0 >= (unsigned)O_DMY ? lds : sl_) + loff0) = R##S##_0;                           \
    *(uint4*)((loff1 >= (unsigned)O_DMY ? lds : sl_) + loff1) = R##S##_1;                           \
    *(uint4*)((loff2 >= (unsigned)O_DMY ? lds : sl_) + loff2) = R##S##_2;                           \
    *(uint4*)((loff3 >= (unsigned)O_DMY ? lds : sl_) + loff3) = R##S##_3;                           \
    *(uint4*)((loff4 >= (unsigned)O_DMY ? lds : sl_) + loff4) = R##S##_4;                           \
    *(uint4*)((loff5 >= (unsigned)O_DMY ? lds : sl_) + loff5) = R##S##_5;                           \
    *(uint4*)((loff6 >= (unsigned)O_DMY ? lds : sl_) + loff6) = R##S##_6;                           \
    *(uint4*)((loff7 >= (unsigned)O_DMY ? lds : sl_) + loff7) = R##S##_7;                           \
    if (w == 7) {                      \
      *(uint4*)((loff8 >= (unsigned)O_DMY ? lds : sl_) + loff8) = R##S##_8;                         \
      *(uint4*)((loff9 >= (unsigned)O_DMY ? lds : sl_) + loff9) = R##S##_9;                         \
      *(uint4*)((loff10 >= (unsigned)O_DMY ? lds : sl_) + loff10) = R##S##_10;                         \
      *(uint4*)((loff11 >= (unsigned)O_DMY ? lds : sl_) + loff11) = R##S##_11;                         \
    }                                                                                                     \
  } while (0)
    LD_ISSUE(0, 0);
    LD_ISSUE(1, 1);
    LD_ISSUE(2, 2);
    LD_WRITE(0, 0);
    __syncthreads();
    static_assert(NCH % 3 == 2, "loader tail assumes NCH = 3k + 2");
    for (int n = 0; n < NCH - 2; n += 3) {
      if (n == E1_SPLIT - 8) {
        if (lane == 0) {
          const unsigned want = gridDim.x - 64;
          unsigned spins = 0;
          while (__hip_atomic_load(p.E1DONE, __ATOMIC_RELAXED, __HIP_MEMORY_SCOPE_AGENT) < want && ++spins < (1u << 24)) __builtin_amdgcn_s_sleep(2);
        }
        __builtin_amdgcn_fence(__ATOMIC_ACQUIRE, "agent");
        asm volatile("s_waitcnt vmcnt(0)" ::: "memory");
      }
      LD_ISSUE(0, n + 3); LD_WRITE(1, n + 1); __syncthreads();
      LD_ISSUE(1, n + 4); LD_WRITE(2, n + 2); __syncthreads();
      LD_ISSUE(2, n + 5); LD_WRITE(0, n + 3); __syncthreads();
    }
    LD_WRITE(1, NCH - 1); __syncthreads();
    __syncthreads();
#undef LD_ISSUE
#undef LD_WRITE
  } else if (w == 0) {
    f32x4 Sacc[8];
#pragma unroll
    for (int d = 0; d < 8; ++d) Sacc[d] = (f32x4){0.f, 0.f, 0.f, 0.f};
    __half* rhsT = (__half*)(lds + O_RHS);
    __half* vndT = (__half*)(lds + O_VND);
    __syncthreads();
    int n3 = 0;
    for (int n = 0; n < NCH; ++n) {
      const char* sl = lds + (n & 1) * SLOT;
      const __half* kc = (const __half*)(sl + O_K);
      const __half* tc = (const __half*)(sl + O_T);
      const float* sc = (const float*)(sl + O_SC);
      const __half* STc = (const __half*)(lds + O_ST + n3 * 4352);
      const int n3n = (n3 == 2) ? 0 : n3 + 1;
      __half* STn = (__half*)(lds + O_ST + n3n * 4352);
      __half* vnT = (__half*)(lds + O_VN + (n & 1) * 2304);
      f16x8 Sf[4], kfr[4][4], tf[6];
      f32x4 be[4], bt[4], dd[4];
      unsigned short uv[4][4];
#pragma unroll
      for (int kk = 0; kk < 4; ++kk) Sf[kk] = *(const f16x8*)(STc + fr * 136 + 32 * kk + 8 * fq);
#pragma unroll
      for (int m = 0; m < 4; ++m) {
#pragma unroll
        for (int kk = 0; kk < 4; ++kk) kfr[m][kk] = *(const f16x8*)(kc + (16 * m + fr) * 136 + 32 * kk + 8 * fq);
        be[m] = *(const f32x4*)(sc + 16 * m + 4 * fq);
        bt[m] = *(const f32x4*)(sc + 192 + 16 * m + 4 * fq);
        dd[m] = *(const f32x4*)(sc + 64 + 16 * m + 4 * fq);
        const unsigned short* vp = (const unsigned short*)(sl + O_V) + (16 * m + 4 * fq) * 16 + fr;
        uv[m][0] = vp[0]; uv[m][1] = vp[16]; uv[m][2] = vp[32]; uv[m][3] = vp[48];
      }
      tf[0] = *(const f16x8*)(tc + (0 + fr) * 72 + 8 * fq);
      tf[1] = *(const f16x8*)(tc + (16 + fr) * 72 + 8 * fq);
      tf[2] = *(const f16x8*)(tc + (32 + fr) * 72 + 8 * fq);
      tf[3] = *(const f16x8*)(tc + (32 + fr) * 72 + 32 + 8 * fq);
      tf[4] = *(const f16x8*)(tc + (48 + fr) * 72 + 8 * fq);
      tf[5] = *(const f16x8*)(tc + (48 + fr) * 72 + 32 + 8 * fq);
      const float glast = sc[256];
      __builtin_amdgcn_sched_barrier(0);
      f32x4 ks[4];
#pragma unroll
      for (int m = 0; m < 4; ++m) ks[m] = (f32x4){0.f, 0.f, 0.f, 0.f};
#pragma unroll
      for (int kk = 0; kk < 4; ++kk)
#pragma unroll
        for (int m = 0; m < 4; ++m) ks[m] = MFMA16(kfr[m][kk], Sf[kk], ks[m]);
#pragma unroll
      for (int m = 0; m < 4; ++m) {
        f32x4 rhs;
#pragma unroll
        for (int r = 0; r < 4; ++r) rhs[r] = bt[m][r] * __half2float(__ushort_as_half(uv[m][r])) - be[m][r] * ks[m][r];
        store_h4(rhsT + fr * 72 + 16 * m + 4 * fq, rhs);
      }
      f16x8 rf[2];
      rf[0] = *(const f16x8*)(rhsT + fr * 72 + 8 * fq);
      rf[1] = *(const f16x8*)(rhsT + fr * 72 + 32 + 8 * fq);
      f16x8 ktf[8][2];
#pragma unroll
      for (int d = 0; d < 8; ++d)
#pragma unroll
        for (int kk = 0; kk < 2; ++kk) {
          const __half* kb = kc + (32 * kk + 8 * fq + (fr >> 2)) * 136 + 16 * d + 4 * (fr & 3);
          const h16x4 lo = __builtin_amdgcn_ds_read_tr16_b64_v4f16((__attribute__((address_space(3))) h16x4*)(kb));
          const h16x4 hi = __builtin_amdgcn_ds_read_tr16_b64_v4f16((__attribute__((address_space(3))) h16x4*)(kb + 4 * 136));
          const f16x4 lo4 = __builtin_bit_cast(f16x4, lo), hi4 = __builtin_bit_cast(f16x4, hi);
          ktf[d][kk] = (f16x8){lo4[0], lo4[1], lo4[2], lo4[3], hi4[0], hi4[1], hi4[2], hi4[3]};
        }
      __builtin_amdgcn_sched_barrier(0);
      f32x4 vnv[4];
      vnv[0] = MFMA16(tf[0], rf[0], ((f32x4){0.f, 0.f, 0.f, 0.f}));
      vnv[1] = MFMA16(tf[1], rf[0], ((f32x4){0.f, 0.f, 0.f, 0.f}));
      vnv[2] = MFMA16(tf[2], rf[0], ((f32x4){0.f, 0.f, 0.f, 0.f}));
      vnv[3] = MFMA16(tf[4], rf[0], ((f32x4){0.f, 0.f, 0.f, 0.f}));
      vnv[2] = MFMA16(tf[3], rf[1], vnv[2]);
      vnv[3] = MFMA16(tf[5], rf[1], vnv[3]);
#pragma unroll
      for (int m = 0; m < 4; ++m) {
        store_h4(vnT + fr * 72 + 16 * m + 4 * fq, vnv[m]);
        f32x4 vd;
#pragma unroll
        for (int r = 0; r < 4; ++r) vd[r] = vnv[m][r] * dd[m][r];
        store_h4(vndT + fr * 72 + 16 * m + 4 * fq, vd);
      }
      f16x8 vdf[2];
      vdf[0] = *(const f16x8*)(vndT + fr * 72 + 8 * fq);
      vdf[1] = *(const f16x8*)(vndT + fr * 72 + 32 + 8 * fq);
#pragma unroll
      for (int d = 0; d < 8; ++d)
#pragma unroll
        for (int r = 0; r < 4; ++r) Sacc[d][r] *= glast;
      __builtin_amdgcn_sched_barrier(0);
#pragma unroll
      for (int kk = 0; kk < 2; ++kk)
#pragma unroll
        for (int d = 0; d < 8; ++d) Sacc[d] = MFMA16(ktf[d][kk], vdf[kk], Sacc[d]);
#pragma unroll
      for (int d = 0; d < 8; ++d) store_h4(STn + fr * 136 + 16 * d + 4 * fq, Sacc[d]);
      n3 = n3n;
      __syncthreads();
    }
  } else {
    f32x4 accq[4], sep[4];
    f16x8 qkp[4][2];
#pragma unroll
    for (int m = 0; m < 4; ++m) {
      accq[m] = (f32x4){0.f, 0.f, 0.f, 0.f};
      sep[m] = (f32x4){0.f, 0.f, 0.f, 0.f};
      qkp[m][0] = (f16x8){};
      qkp[m][1] = (f16x8){};
    }
    const unsigned ocol = (hd * 128 + e0 + fr) * 2u;
    auto emit = [&](int np) {
      const __half* vnT = (const __half*)(lds + O_VN + (np & 1) * 2304);
      f16x8 vf[2];
      vf[0] = *(const f16x8*)(vnT + fr * 72 + 8 * fq);
      vf[1] = *(const f16x8*)(vnT + fr * 72 + 32 + 8 * fq);
      char* ob = (char*)(Od + (size_t)rowbase(np) * 512);
      __builtin_amdgcn_sched_barrier(0);
      f32x4 o[4];
#pragma unroll
      for (int m = 0; m < 4; ++m)
#pragma unroll
        for (int r = 0; r < 4; ++r) o[m][r] = sep[m][r] * accq[m][r];
#pragma unroll
      for (int m = 0; m < 4; ++m) o[m] = MFMA16(qkp[m][0], vf[0], o[m]);
      o[2] = MFMA16(qkp[2][1], vf[1], o[2]);
      o[3] = MFMA16(qkp[3][1], vf[1], o[3]);
      if (np >= 4) {
#pragma unroll
        for (int m = 0; m < 4; ++m)
#pragma unroll
          for (int r = 0; r < 4; ++r) *(__half*)(ob + relrow(16 * m + 4 * fq + r) * 1024u + ocol) = __float2half(o[m][r]);
      }
    };
    __syncthreads();
    int n3 = 0;
    for (int n = 0; n < NCH; ++n) {
      const char* sl = lds + (n & 1) * SLOT;
      const __half* qc = (const __half*)(sl + O_Q);
      const __half* mc = (const __half*)(sl + O_QK);
      const float* sc = (const float*)(sl + O_SC);
      const __half* STc = (const __half*)(lds + O_ST + n3 * 4352);
      if (n > 0) emit(n - 1);
      f16x8 Sf[4], qfr[4][4];
#pragma unroll
      for (int kk = 0; kk < 4; ++kk) Sf[kk] = *(const f16x8*)(STc + fr * 136 + 32 * kk + 8 * fq);
#pragma unroll
      for (int m = 0; m < 4; ++m) {
#pragma unroll
        for (int kk = 0; kk < 4; ++kk) qfr[m][kk] = *(const f16x8*)(qc + (16 * m + fr) * 136 + 32 * kk + 8 * fq);
        sep[m] = *(const f32x4*)(sc + 128 + 16 * m + 4 * fq);
        qkp[m][0] = *(const f16x8*)(mc + (16 * m + fr) * 72 + 8 * fq);
        qkp[m][1] = *(const f16x8*)(mc + (16 * m + fr) * 72 + 32 + 8 * fq);
      }
      __builtin_amdgcn_sched_barrier(0);
#pragma unroll
      for (int m = 0; m < 4; ++m) accq[m] = (f32x4){0.f, 0.f, 0.f, 0.f};
#pragma unroll
      for (int kk = 0; kk < 4; ++kk)
#pragma unroll
        for (int m = 0; m < 4; ++m) accq[m] = MFMA16(qfr[m][kk], Sf[kk], accq[m]);
      n3 = (n3 == 2) ? 0 : n3 + 1;
      __syncthreads();
    }
    emit(NCH - 1);
  }
}

__device__ void phaseF(const Params& p, int tid) {
  const int lane = tid & 63;
  const int gw = blockIdx.x * NWV + (tid >> 6);
  const int nw = gridDim.x * NWV;
  const f32x4 nw0 = *(const f32x4*)(p.gdn_norm_w + (lane & 15) * 8), nw1 = *(const f32x4*)(p.gdn_norm_w + (lane & 15) * 8 + 4);
  for (int t0 = gw; t0 < L; t0 += 2 * nw) {
    f16x8 vf[2], vb[2], z[2];
#pragma unroll
    for (int u = 0; u < 2; ++u) {
      const size_t o = (size_t)min(t0 + u * nw, L - 1) * 512 + lane * 8;
      vf[u] = *(const f16x8*)(p.OF + o);
      vb[u] = *(const f16x8*)(p.OB + o);
      z[u] = *(const f16x8*)(p.GZ + o);
    }
#pragma unroll
    for (int u = 0; u < 2; ++u) {
      const int t = t0 + u * nw;
      if (t >= L) break;
      float v[8];
      float ss = 0.f;
#pragma unroll
      for (int e = 0; e < 8; ++e) {
        v[e] = (float)vf[u][e] + (float)vb[u][e];
        ss += v[e] * v[e];
      }
      ss += __shfl_xor(ss, 1, 64);
      ss += __shfl_xor(ss, 2, 64);
      ss += __shfl_xor(ss, 4, 64);
      ss += __shfl_xor(ss, 8, 64);
      const float inv = rsqrtf(ss * (1.f / 128.f) + EPS);
      __half2 h[4];
#pragma unroll
      for (int e = 0; e < 4; ++e) {
        const float w0 = (2 * e < 4) ? nw0[2 * e] : nw1[2 * e - 4], w1 = (2 * e + 1 < 4) ? nw0[2 * e + 1] : nw1[2 * e + 1 - 4];
        h[e] = __floats2half2_rn(v[2 * e] * inv * w0 * siluf((float)z[u][2 * e]), v[2 * e + 1] * inv * w1 * siluf((float)z[u][2 * e + 1]));
      }
      *(uint4*)(p.MIX + (size_t)t * 1024 + 512 + lane * 8) = *(uint4*)h;
    }
  }
}

__device__ void phaseG(const Params& p, __half* shm, int tid) {
  auto epi = [&](int brow, int bcol, const f32x4(&acc)[2][2][4][2], int r0, int c0) {
#pragma unroll
    for (int ai = 0; ai < 2; ++ai)
#pragma unroll
      for (int m = 0; m < 4; ++m) {
        __half* rowp = p.Y + (size_t)(brow + ai * 128 + m * 16 + r0) * 1024 + bcol + c0;
#pragma unroll
        for (int bj = 0; bj < 2; ++bj)
#pragma unroll
          for (int n = 0; n < 2; ++n) store_h4(rowp + bj * 128 + n * 16, acc[ai][bj][m][n]);
      }
  };
  gemm_mfma<64, 4, 0, 256, 0, 0>(p.MIX, p.WtO, shm, tid, 0, gridDim.x, epi);
}

__device__ void phaseH(const Params& p, int tid) {
  int lane = tid & 63;
  int gw = blockIdx.x * NWV + (tid >> 6);
  int nw = gridDim.x * NWV;
  float4 gg[2][2];
#pragma unroll
  for (int i = 0; i < 2; ++i)
#pragma unroll
    for (int hh = 0; hh < 2; ++hh) {
      const int j = i * 512 + lane * 8 + 4 * hh;
      const float4 g = *(const float4*)(p.g_post + j), gt = *(const float4*)(p.mod + 2048 + j);
      gg[i][hh] = make_float4(g.x * gt.x, g.y * gt.y, g.z * gt.z, g.w * gt.w);
    }
  for (int r0 = gw; r0 < L; r0 += 2 * nw) {
    f16x8 y[2][2];
    float4 xv[2][2][2];
#pragma unroll
    for (int u = 0; u < 2; ++u) {
      const int r = min(r0 + u * nw, L - 1);
#pragma unroll
      for (int i = 0; i < 2; ++i) {
        const int j = i * 512 + lane * 8;
        y[u][i] = *(const f16x8*)(p.Y + (size_t)r * D + j);
        xv[u][i][0] = *(const float4*)(p.x + (size_t)r * D + j);
        xv[u][i][1] = *(const float4*)(p.x + (size_t)r * D + j + 4);
      }
    }
#pragma unroll
    for (int u = 0; u < 2; ++u) {
      const int r = r0 + u * nw;
      if (r >= L) break;
      float ss = 0.f;
#pragma unroll
      for (int i = 0; i < 2; ++i)
#pragma unroll
        for (int e = 0; e < 8; ++e) ss += (float)y[u][i][e] * (float)y[u][i][e];
      ss = wsum(ss);
      const float inv = rsqrtf(ss * (1.f / D) + EPS);
#pragma unroll
      for (int i = 0; i < 2; ++i) {
        const int j = i * 512 + lane * 8;
#pragma unroll
        for (int hh = 0; hh < 2; ++hh) {
          const float4 x4 = xv[u][i][hh], f = gg[i][hh];
          float4 o;
          o.x = x4.x + f.x * ((float)y[u][i][4 * hh + 0] * inv);
          o.y = x4.y + f.y * ((float)y[u][i][4 * hh + 1] * inv);
          o.z = x4.z + f.z * ((float)y[u][i][4 * hh + 2] * inv);
          o.w = x4.w + f.w * ((float)y[u][i][4 * hh + 3] * inv);
          *(float4*)(p.out + (size_t)r * D + j + 4 * hh) = o;
        }
      }
    }
  }
}

__device__ __forceinline__ int fresh_tid(int wave_s) {
  int lane;
  asm volatile("v_mbcnt_lo_u32_b32 %0, -1, 0\n\tv_mbcnt_hi_u32_b32 %0, -1, %0" : "=v"(lane));
  return wave_s * 64 + lane;
}

constexpr size_t al256(size_t b) { return (b + 255) & ~(size_t)255; }
constexpr size_t OFF_MOD = 0;
constexpr size_t OFF_WTI = OFF_MOD + al256(2 * 3072 * 4);
constexpr size_t OFF_WTO = OFF_WTI + al256((size_t)NPAD * 1024 * 2);
constexpr size_t OFF_H = OFF_WTO + al256((size_t)1024 * 1024 * 2);
constexpr size_t OFF_NAP = OFF_H + al256((size_t)LT * 1024 * 2);
constexpr size_t OFF_VT = OFF_NAP + al256((size_t)LT * 1536 * 2);
constexpr size_t OFF_GQ = OFF_VT + al256((size_t)512 * LT * 2);
constexpr size_t OFF_GZ = OFF_GQ + al256((size_t)LT * 1536 * 2);
constexpr size_t OFF_GBA = OFF_GZ + al256((size_t)LT * 512 * 2);
constexpr size_t OFF_QKV = OFF_GBA + al256((size_t)LT * 16 * 4);
constexpr size_t OFF_BETA = OFF_QKV + al256((size_t)LT * 1536 * 2);
constexpr size_t OFF_GG = OFF_BETA + al256((size_t)LT * 8 * 4);
constexpr size_t OFF_QKM = OFF_GG + al256((size_t)LT * 8 * 4);
constexpr size_t OFF_SC = OFF_QKM + al256((size_t)8 * 260 * 4096 * 2);
constexpr size_t OFF_ROPE = OFF_SC + al256((size_t)8 * 260 * 320 * 4);
constexpr size_t OFF_BAR = OFF_ROPE + al256((size_t)320 * 32 * 2 * 4) + 256;
constexpr size_t WS_TOTAL = OFF_BAR + al256((size_t)3456 * 4);
static_assert(WS_TOTAL <= (size_t)256 * 1024 * 1024, "workspace map exceeds 256 MiB");

struct KArgs {
  const float* in[15];
  float* out;
  char* ws;
};

__device__ __forceinline__ Params make_params(const KArgs& a) {
  unsigned long long wsi = (unsigned long long)a.ws;
  asm volatile("" : "+s"(wsi));
  char* ws = (char*)(__attribute__((address_space(1))) char*)wsi;
  Params p;
  p.x = a.in[0]; p.c = a.in[1]; p.ctx = a.in[2]; p.c_ctx = a.in[3]; p.w_ada = a.in[4]; p.b_ada = a.in[5];
  p.g_pre = a.in[6]; p.g_post = a.in[7]; p.w_in = a.in[8]; p.conv_w = a.in[9]; p.rpb = a.in[10];
  p.A_log = a.in[11]; p.dt_bias = a.in[12]; p.gdn_norm_w = a.in[13]; p.w_out = a.in[14];
  p.out = a.out;
  p.mod = (float*)(ws + OFF_MOD);
  p.WtI = (__half*)(ws + OFF_WTI);
  p.WtO = (__half*)(ws + OFF_WTO);
  p.H = (__half*)(ws + OFF_H);
  p.MIX = p.H;
  p.NAP = (__half*)(ws + OFF_NAP);
  p.VT = (__half*)(ws + OFF_VT);
  p.Y = (__half*)(ws + OFF_NAP);
  p.GQ = (__half*)(ws + OFF_GQ);
  p.OF = p.GQ;
  p.OB = p.GQ + (size_t)L * 512;
  p.TB = p.GQ + (size_t)2 * L * 512;
  p.GZ = (__half*)(ws + OFF_GZ);
  p.GBA = (float*)(ws + OFF_GBA);
  p.QKV = (__half*)(ws + OFF_QKV);
  p.BETA = (float*)(ws + OFF_BETA);
  p.GG = (float*)(ws + OFF_GG);
  p.QKM = (__half*)(ws + OFF_QKM);
  p.SC = (float*)(ws + OFF_SC);
  p.ROPE = (float*)(ws + OFF_ROPE);
  p.E1DONE = (unsigned*)(ws + OFF_BAR) + 64;
  return p;
}

#define XB_TMO 128
#define XB_XCNT(j) (256 + 64 * (j))
#define XB_XSUB(j) (1280 + 64 * (j))
#define XB_XGEN(j) (2304 + 64 * (j))
#define XB_TOP 3328
#define XB_TOPGEN 3392
#define XCD_BAR_WORDS 3456
#define XB_SPIN_CAP (1u << 18)
#define XB_LAS __attribute__((address_space(3)))
__device__ __forceinline__ unsigned xb_ld(unsigned* p) { return __hip_atomic_load(p, __ATOMIC_RELAXED, __HIP_MEMORY_SCOPE_AGENT); }
__device__ __forceinline__ unsigned xb_add(unsigned* p, unsigned v) { return __hip_atomic_fetch_add(p, v, __ATOMIC_RELAXED, __HIP_MEMORY_SCOPE_AGENT); }
__device__ __forceinline__ unsigned xb_xcc_id() { return (unsigned)__builtin_amdgcn_s_getreg((3 << 11) | 20) & 0xFu; }
#define XB_SPIN(cond, bar)                                                   \
  do {                                                                       \
    unsigned _sp = 0;                                                        \
    while (cond) {                                                           \
      __builtin_amdgcn_s_sleep(1);                                           \
      if ((++_sp & 255u) == 0u) {                                            \
        if (xb_ld(&(bar)[XB_TMO])) break;                                    \
        if (_sp > XB_SPIN_CAP) {                                             \
          atomicAdd(&(bar)[XB_TMO], 1u);                                     \
          break;                                                             \
        }                                                                    \
      }                                                                      \
    }                                                                        \
  } while (0)
struct XcdBarrier {
  unsigned* bar;
  unsigned x;
  volatile XB_LAS unsigned* st;
};
__device__ __forceinline__ XcdBarrier xcd_barrier_post(unsigned* bar, volatile XB_LAS unsigned* st) {
  XcdBarrier b;
  b.bar = bar;
  b.x = xb_xcc_id();
  b.st = st;
  if (threadIdx.x == 0) (void)xb_add(&bar[XB_XCNT(b.x)], 1u);
  return b;
}
__device__ __forceinline__ void xcd_barrier_complete(unsigned* bar, unsigned x, unsigned& nloc, unsigned& nx) {
  const unsigned G = gridDim.x * gridDim.y * gridDim.z;
  unsigned sum, cnt, mine, sp = 0u;
  for (;;) {
    sum = 0u; cnt = 0u; mine = 0u;
#pragma unroll
    for (unsigned j = 0; j < 16; ++j) {
      const unsigned c = xb_ld(&bar[XB_XCNT(j)]);
      sum += c;
      cnt += (c > 0u) ? 1u : 0u;
      mine = (j == x) ? c : mine;
    }
    if (sum == G) break;
    __builtin_amdgcn_s_sleep(1);
    if ((++sp & 255u) == 0u) {
      if (xb_ld(&bar[XB_TMO])) break;
      if (sp > XB_SPIN_CAP) {
        atomicAdd(&bar[XB_TMO], 1u);
        break;
      }
    }
  }
  nloc = mine > 0u ? mine : 1u;
  nx = cnt > 0u ? cnt : 1u;
}
__device__ __forceinline__ void xcd_barrier(const XcdBarrier& b) {
  asm volatile("s_waitcnt vmcnt(0)" ::: "memory");
  __syncthreads();
  if (threadIdx.x == 0) {
    unsigned* bar = b.bar;
    __builtin_amdgcn_s_waitcnt(0);
    unsigned nloc = b.st[0], nx = b.st[1];
    if (nloc == 0u) {
      xcd_barrier_complete(bar, b.x, nloc, nx);
      b.st[0] = nloc;
      b.st[1] = nx;
    }
    const unsigned old = xb_add(&bar[XB_XSUB(b.x)], 1u);
    const unsigned gen = old / nloc;
    if (old + 1u == (gen + 1u) * nloc) {
      __builtin_amdgcn_fence(__ATOMIC_RELEASE, "agent");
      asm volatile("s_waitcnt vmcnt(0)" ::: "memory");
      const unsigned og = xb_add(&bar[XB_TOP], 1u);
      const unsigned tg = og / nx;
      if (og + 1u == (tg + 1u) * nx) xb_add(&bar[XB_TOPGEN], 1u);
      else XB_SPIN(xb_ld(&bar[XB_TOPGEN]) == tg, bar);
      __builtin_amdgcn_fence(__ATOMIC_ACQUIRE, "agent");
      xb_add(&bar[XB_XGEN(b.x)], 1u);
      asm volatile("s_waitcnt vmcnt(0)" ::: "memory");
    } else {
      XB_SPIN(xb_ld(&bar[XB_XGEN(b.x)]) == gen, bar);
      __builtin_amdgcn_fence(__ATOMIC_ACQUIRE, "agent");
      asm volatile("s_waitcnt vmcnt(0)" ::: "memory");
    }
  }
  __syncthreads();
}

__device__ __forceinline__ void grid_barrier(unsigned* ctr, unsigned target) {
  asm volatile("s_waitcnt vmcnt(0)" ::: "memory");
  __syncthreads();
  if (threadIdx.x == 0) {
    __builtin_amdgcn_fence(__ATOMIC_RELEASE, "agent");
    asm volatile("s_waitcnt vmcnt(0)" ::: "memory");
    __hip_atomic_fetch_add(ctr, 1u, __ATOMIC_RELAXED, __HIP_MEMORY_SCOPE_AGENT);
    unsigned spins = 0;
    while (__hip_atomic_load(ctr, __ATOMIC_RELAXED, __HIP_MEMORY_SCOPE_AGENT) < target && ++spins < (1u << 24))
      __builtin_amdgcn_s_sleep(1);
    __builtin_amdgcn_fence(__ATOMIC_ACQUIRE, "agent");
    asm volatile("s_waitcnt vmcnt(0)" ::: "memory");
  }
  __syncthreads();
}

template <int PH>
__device__ void run_phase(const KArgs& a, float* smem, int wave_s) {
  const int tid = fresh_tid(wave_s);
  const Params p = make_params(a);
  if constexpr (PH == 0) phaseA(p, smem, tid);
  if constexpr (PH == 1) phaseB(p, tid);
  if constexpr (PH == 2) phaseC(p, (__half*)smem, tid, true, 0, gridDim.x);
  if constexpr (PH == 3) phaseD_gdnpre(p, tid);
  if constexpr (PH == 4) {
    if (blockIdx.x < 81) {
      int tg = tid;
      asm volatile("" : "+v"(tg));
      phaseC(p, (__half*)smem, tg, false, 0, 81);
    } else {
      int te = tid;
      asm volatile("" : "+v"(te));
      phaseE1(p, smem, te, 81, gridDim.x - 81, 0, 8 * E1_SPLIT);
    }
  }
  if constexpr (PH == 8) {
    if (blockIdx.x < 64) {
      phaseE2(p, smem, tid);
    } else {
      phaseE1(p, smem, tid, 64, gridDim.x - 64, 8 * E1_SPLIT, 8 * NCH);
      asm volatile("s_waitcnt vmcnt(0)" ::: "memory");
      __syncthreads();
      if (tid == 0) {
        __builtin_amdgcn_fence(__ATOMIC_RELEASE, "agent");
        asm volatile("s_waitcnt vmcnt(0)" ::: "memory");
        __hip_atomic_fetch_add(p.E1DONE, 1u, __ATOMIC_RELAXED, __HIP_MEMORY_SCOPE_AGENT);
      }
      {
        int tn = tid;
        asm volatile("" : "+v"(tn));
        phaseNA(p, smem, tn, 64, gridDim.x - 64);
      }
    }
  }
  if constexpr (PH == 5) phaseF(p, tid);
  if constexpr (PH == 6) phaseG(p, (__half*)smem, tid);
  if constexpr (PH == 7) phaseH(p, tid);
}

__global__ void __launch_bounds__(NT, 2) mega(KArgs a) {
  extern __shared__ __attribute__((aligned(16))) float smem[];
  cg::grid_group grid = cg::this_grid();
  const int wave_s = __builtin_amdgcn_readfirstlane((int)(hipThreadIdx_x >> 6));
#ifdef TPROBE
#define TSTAMP(k) ts##k = wall_clock64()
  unsigned long long ts0 = 0, ts1 = 0, ts2 = 0, ts3 = 0, ts4 = 0, ts5 = 0, ts6 = 0, ts7 = 0, ts8 = 0;
#else
#define TSTAMP(k)
#endif
  unsigned* const bar = (unsigned*)(a.ws + OFF_BAR);
  volatile XB_LAS unsigned* const xst = (volatile XB_LAS unsigned*)((XB_LAS char*)smem + (LDS_BYTES - 16));
  if (blockIdx.x == 0)
    for (int i = threadIdx.x; i < XCD_BAR_WORDS; i += NT) __hip_atomic_store(bar + i, 0u, __ATOMIC_RELAXED, __HIP_MEMORY_SCOPE_AGENT);
  if (threadIdx.x == 0) {
    xst[0] = 0u;
    xst[1] = 0u;
  }
  TSTAMP(0);
  grid.sync();
  const XcdBarrier xb = xcd_barrier_post(bar, xst);
  run_phase<0>(a, smem, wave_s); TSTAMP(1);
  run_phase<1>(a, smem, wave_s); xcd_barrier(xb); TSTAMP(2);
  run_phase<2>(a, smem, wave_s); xcd_barrier(xb); TSTAMP(3);
  run_phase<3>(a, smem, wave_s); xcd_barrier(xb); TSTAMP(4);
  run_phase<4>(a, smem, wave_s); xcd_barrier(xb); TSTAMP(5);
  run_phase<8>(a, smem, wave_s); xcd_barrier(xb); TSTAMP(6);
  run_phase<5>(a, smem, wave_s); xcd_barrier(xb); TSTAMP(7);
  run_phase<6>(a, smem, wave_s); xcd_barrier(xb); TSTAMP(8);
  run_phase<7>(a, smem, wave_s);
#ifdef TPROBE
  __syncthreads();
  if (blockIdx.x == 0) {
    int cnt = (int)((TPROBE_HI - TPROBE_LO) / 100);
    cnt = cnt > 1000 ? 1000 : cnt;
    for (int i = threadIdx.x; i < cnt; i += NT) a.out[i] += 0.1f;
  }
#endif
}

extern "C" void kernel_launch(void* const* d_in, const int* in_sizes, int n_in, void* d_out, int out_size, void* d_ws,
                              size_t ws_size, hipStream_t stream) {
  KArgs a{};
  for (int i = 0; i < 15; ++i) a.in[i] = (const float*)d_in[i];
  a.out = (float*)d_out;
  a.ws = (char*)d_ws;
  static int grid_blocks = 0;
  if (!grid_blocks) {
    int dev = 0, cus = 0, per_cu = 0;
    (void)hipGetDevice(&dev);
    (void)hipDeviceGetAttribute(&cus, hipDeviceAttributeMultiprocessorCount, dev);
    (void)hipFuncSetAttribute((const void*)mega, hipFuncAttributeMaxDynamicSharedMemorySize, LDS_BYTES);
    (void)hipOccupancyMaxActiveBlocksPerMultiprocessor(&per_cu, mega, NT, LDS_BYTES);
    if (per_cu < 1) per_cu = 1;
    grid_blocks = cus * per_cu;
  }
  void* args[] = {&a};
  hipError_t e = hipLaunchCooperativeKernel((void*)mega, dim3(grid_blocks), dim3(NT), args, LDS_BYTES, stream);
  if (e != hipSuccess) fprintf(stderr, "cooperative launch failed: %s (grid %d)\n", hipGetErrorString(e), grid_blocks);
}

#ifdef DIAG_PHASES
template <int PH>
__global__ void __launch_bounds__(NT, 2) phase_k(KArgs a) {
  extern __shared__ __attribute__((aligned(16))) float smem[];
  run_phase<PH>(a, smem, (int)(hipThreadIdx_x >> 6));
}
template __global__ void phase_k<2>(KArgs);
template __global__ void phase_k<3>(KArgs);
template __global__ void phase_k<4>(KArgs);
template __global__ void phase_k<8>(KArgs);
template __global__ void phase_k<6>(KArgs);
#endif
```
